# Optimizing an MI355X kernel written in HIP

```python
import math
import jax, jax.numpy as jnp
from jax import lax
import numpy as np

D_MODEL = 2048
BATCH = 8
SEQ = 2048
DEPTH = 1

MIX_WIDTH = D_MODEL
DIFF_WIDTH = MIX_WIDTH // 2
SB_WIDTH = MIX_WIDTH - DIFF_WIDTH
DIFF_HEADS = 4
DIFF_QK_DIM = DIFF_WIDTH // (2 * DIFF_HEADS)
DIFF_V_DIM = 2 * DIFF_QK_DIM
SB_HEADS = 8
SB_HEAD_DIM = SB_WIDTH // SB_HEADS
D_FF = ((8 * D_MODEL // 3 + 255) // 256) * 256
ROPE_THETA = 500000.0
ROPE_DIM = DIFF_QK_DIM // 4
Q_BLOCK = 128
EPS = 1e-5
DIFF_QK_COLS = DIFF_HEADS * DIFF_QK_DIM
DIFF_V_COLS = DIFF_HEADS * DIFF_V_DIM
IN_COLS = 4 * DIFF_QK_COLS + DIFF_V_COLS + 3 * SB_WIDTH

kernel_name = "hybrid_diffattn_stickbreaking_macaron"


def _rmsnorm(x, g):
    xf = x.astype(jnp.float32)
    y = xf * lax.rsqrt(jnp.mean(xf * xf, axis=-1, keepdims=True) + EPS)
    return (y * g.astype(jnp.float32)).astype(x.dtype)


def _swiglu(x, w_gate, w_up, w_down):
    return (jax.nn.silu(x @ w_gate) * (x @ w_up)) @ w_down


def _rope_tables(seq):
    pos = jnp.arange(seq, dtype=jnp.float32)
    inv_freq = ROPE_THETA ** (-jnp.arange(0, ROPE_DIM, 2, dtype=jnp.float32) / ROPE_DIM)
    ang = pos[:, None] * inv_freq[None, :]
    return jnp.cos(ang)[None, :, None, :], jnp.sin(ang)[None, :, None, :]


def _partial_rope(x, cos, sin):
    xf = x.astype(jnp.float32)
    half = ROPE_DIM // 2
    x1, x2, rest = xf[..., :half], xf[..., half:ROPE_DIM], xf[..., ROPE_DIM:]
    out = jnp.concatenate([x1 * cos - x2 * sin, x2 * cos + x1 * sin, rest], axis=-1)
    return out.astype(x.dtype)


def _softmax_map(q, k, mask, t0, t1):
    s = jnp.einsum('bqhd,bkhd->bhqk', q[:, t0:t1], k[:, :t1]).astype(jnp.float32) * (DIFF_QK_DIM ** -0.5)
    return jax.nn.softmax(jnp.where(mask, s, -jnp.inf), axis=-1)


def _diff_attention(q1, q2, k1, k2, v, lam):
    seq = q1.shape[1]
    vf = v.astype(jnp.float32)
    outs = []
    for i in range(seq // Q_BLOCK):
        t0, t1 = i * Q_BLOCK, (i + 1) * Q_BLOCK
        mask = jnp.arange(t0, t1)[:, None] >= jnp.arange(t1)[None, :]
        w = _softmax_map(q1, k1, mask, t0, t1) - lam * _softmax_map(q2, k2, mask, t0, t1)
        outs.append(jnp.einsum('bhqk,bkhd->bqhd', w, vf[:, :t1]))
    return jnp.concatenate(outs, axis=1)


def _stick_breaking(q, k, v):
    seq = q.shape[1]
    vf = v.astype(jnp.float32)
    scale = SB_HEAD_DIM ** -0.5
    outs = []
    for i in range(seq // Q_BLOCK):
        t0, t1 = i * Q_BLOCK, (i + 1) * Q_BLOCK
        mask = jnp.arange(t0, t1)[:, None] > jnp.arange(t1)[None, :]
        z = jnp.einsum('bqhd,bkhd->bhqk', q[:, t0:t1], k[:, :t1]).astype(jnp.float32) * scale
        log_1m_beta = jnp.where(mask, jax.nn.log_sigmoid(-z), 0.0)
        tail = lax.cumsum(log_1m_beta, axis=3, reverse=True) - log_1m_beta
        a = jnp.where(mask, jnp.exp(jax.nn.log_sigmoid(z) + tail), 0.0)
        outs.append(jnp.einsum('bhqk,bkhd->bqhd', a, vf[:, :t1]))
    return jnp.concatenate(outs, axis=1)


def setup_inputs(seed: int = 0) -> dict:
    key = jax.random.key(seed)
    ks = jax.random.split(key, 24)
    f32 = jnp.float32
    nrm = lambda k, shape, s: jax.random.normal(k, shape, f32) * s
    gain = lambda k, n: 1.0 + 0.01 * jax.random.normal(k, (DEPTH, n), f32)
    return {
        "x": jax.random.normal(ks[0], (BATCH, SEQ, D_MODEL), f32),
        "ffn1_norm": gain(ks[1], D_MODEL),
        "ffn1_w_gate": nrm(ks[2], (DEPTH, D_MODEL, D_FF), D_MODEL ** -0.5),
        "ffn1_w_up": nrm(ks[3], (DEPTH, D_MODEL, D_FF), D_MODEL ** -0.5),
        "ffn1_w_down": nrm(ks[4], (DEPTH, D_FF, D_MODEL), D_FF ** -0.5),
        "mix_norm": gain(ks[5], D_MODEL),
        "w_in": nrm(ks[6], (DEPTH, D_MODEL, IN_COLS), D_MODEL ** -0.5),
        "q_norm": gain(ks[7], DIFF_QK_DIM),
        "k_norm": gain(ks[8], DIFF_QK_DIM),
        "lambda_q1": nrm(ks[9], (DEPTH, DIFF_QK_DIM), 0.1),
        "lambda_k1": nrm(ks[10], (DEPTH, DIFF_QK_DIM), 0.1),
        "lambda_q2": nrm(ks[11], (DEPTH, DIFF_QK_DIM), 0.1),
        "lambda_k2": nrm(ks[12], (DEPTH, DIFF_QK_DIM), 0.1),
        "subln": gain(ks[13], DIFF_V_DIM),
        "w_out": nrm(ks[14], (DEPTH, MIX_WIDTH, D_MODEL), MIX_WIDTH ** -0.5),
        "ffn2_norm": gain(ks[15], D_MODEL),
        "ffn2_w_gate": nrm(ks[16], (DEPTH, D_MODEL, D_FF), D_MODEL ** -0.5),
        "ffn2_w_up": nrm(ks[17], (DEPTH, D_MODEL, D_FF), D_MODEL ** -0.5),
        "ffn2_w_down": nrm(ks[18], (DEPTH, D_FF, D_MODEL), D_FF ** -0.5),
        "final_norm": gain(ks[19], D_MODEL),
    }


def reference(x, ffn1_norm, ffn1_w_gate, ffn1_w_up, ffn1_w_down, mix_norm, w_in, q_norm, k_norm,
              lambda_q1, lambda_k1, lambda_q2, lambda_k2, subln, w_out,
              ffn2_norm, ffn2_w_gate, ffn2_w_up, ffn2_w_down, final_norm):
    b, s, _ = x.shape
    cos, sin = _rope_tables(s)
    for l in range(DEPTH):
        x = x + 0.5 * _swiglu(_rmsnorm(x, ffn1_norm[l]), ffn1_w_gate[l], ffn1_w_up[l], ffn1_w_down[l])

        u = _rmsnorm(x, mix_norm[l]) @ w_in[l]
        c = np.cumsum([0, DIFF_QK_COLS, DIFF_QK_COLS, DIFF_QK_COLS, DIFF_QK_COLS,
                       DIFF_V_COLS, SB_WIDTH, SB_WIDTH, SB_WIDTH]).tolist()
        q1, q2, k1, k2, dv, sq, sk, sv = [u[..., c[i]:c[i + 1]] for i in range(8)]

        def prep(t, g):
            t = t.reshape(b, s, DIFF_HEADS, DIFF_QK_DIM)
            return _partial_rope(_rmsnorm(t, g), cos, sin)
        q1, q2 = prep(q1, q_norm[l]), prep(q2, q_norm[l])
        k1, k2 = prep(k1, k_norm[l]), prep(k2, k_norm[l])
        dv = dv.reshape(b, s, DIFF_HEADS, DIFF_V_DIM)
        lambda_init = 0.8 - 0.6 * math.exp(-0.3 * l)
        lam = (jnp.exp(jnp.sum(lambda_q1[l].astype(jnp.float32) * lambda_k1[l].astype(jnp.float32)))
               - jnp.exp(jnp.sum(lambda_q2[l].astype(jnp.float32) * lambda_k2[l].astype(jnp.float32)))
               + lambda_init)
        a_out = _diff_attention(q1, q2, k1, k2, dv, lam)
        a_out = _rmsnorm(a_out, subln[l]) * (1.0 - lambda_init)
        a_out = a_out.reshape(b, s, DIFF_WIDTH).astype(x.dtype)

        sq = sq.reshape(b, s, SB_HEADS, SB_HEAD_DIM)
        sk = sk.reshape(b, s, SB_HEADS, SB_HEAD_DIM)
        sv = sv.reshape(b, s, SB_HEADS, SB_HEAD_DIM)
        b_out = _stick_breaking(sq, sk, sv).reshape(b, s, SB_WIDTH).astype(x.dtype)

        x = x + jnp.concatenate([a_out, b_out], axis=-1) @ w_out[l]

        x = x + 0.5 * _swiglu(_rmsnorm(x, ffn2_norm[l]), ffn2_w_gate[l], ffn2_w_up[l], ffn2_w_down[l])

        x = _rmsnorm(x, final_norm[l])
    return x
```

```cpp
#include <hip/hip_cooperative_groups.h>
#include <hip/hip_runtime.h>
#include <cstdio>
#include <cstdint>
namespace pg8 {
#define PG8_LAS __attribute__((address_space(3)))
typedef unsigned short bf16_t;
typedef short bf16x8 __attribute__((ext_vector_type(8)));
typedef float f32x4 __attribute__((ext_vector_type(4)));
typedef unsigned u32x4 __attribute__((ext_vector_type(4)));
constexpr int BM = 256, BK = 64, HALF = 128, HTB = HALF * BK * 2  , STAGE_BYTES = 8 * HTB, NXCD = 8, WGM = 8;

__host__ __device__ __forceinline__ int lds_byte(int r, int c) { const int st = (r >> 4) * 2 + (c >> 5), rr = r & 15, cc = c & 31, ob = rr * 64 + cc * 2; return st * 1024 + (ob ^ (((ob >> 9) & 1) << 5)); }
__host__ __device__ __forceinline__ void stage_rc(int b, int& R, int& C) { const int st = b / 1024, sb = b % 1024, swz = sb ^ (((sb >> 9) & 1) << 5); R = (st >> 1) * 16 + swz / 64; C = (st & 1) * 32 + (swz % 64) / 2; }
__host__ __device__ __forceinline__ int perm32(int rho) { const int n = rho >> 4, i = rho & 15; return 8 * (i >> 2) + 4 * n + (i & 3); }

struct Unit { int pm, pn; };
struct Gemm { const bf16_t* A; const bf16_t* Bt; int M, N, K; };

struct StaticOrder {
    int nM, nN, nwg, G, c;
    __host__ __device__ void init(int M, int N, int G_, int c_) { nM = M / BM; nN = N / BM; nwg = nM * nN; G = G_; c = c_; }
    __host__ __device__ bool next(int i, Unit& u) const {
        const long L = (long)i * G + c; if (L >= nwg) return false;
        int wgid = (int)L; { const int q = nwg / NXCD, r = nwg % NXCD, xcd = wgid % NXCD, off = wgid / NXCD; wgid = (xcd < r ? xcd * (q + 1) : r * (q + 1) + (xcd - r) * q) + off; }
        const int nig = WGM * nN, gid = wgid / nig, fm = gid * WGM, gsz = (nM - fm) < WGM ? (nM - fm) : WGM;
        u.pm = fm + ((wgid % nig) % gsz); u.pn = (wgid % nig) / gsz; return true;
    }
    __device__ __forceinline__ void a_ready(const Unit&) const {}
    __device__ __forceinline__ void done(const Unit&) const {}
};

__device__ __forceinline__ unsigned cvt_pk_bf16(float lo, float hi) { unsigned r; asm volatile("v_cvt_pk_bf16_f32 %0, %1, %2" : "=v"(r) : "v"(lo), "v"(hi)); return r; }
typedef float f32x2 __attribute__((ext_vector_type(2)));
__device__ __forceinline__ f32x2 gelu_pk(f32x2 v) {
    const f32x2 av = __builtin_elementwise_abs(v), d = av * 0.2316418882f + 1.0f;
    f32x2 t; t.x = __builtin_amdgcn_rcpf(d.x); t.y = __builtin_amdgcn_rcpf(d.y);
    f32x2 q = t * 0.5307027145f + (-0.7265760135f); q = q * t + 0.7107068705f; q = q * t + (-0.142248368f); q = q * t + 0.127414796f; q = q * t;
    const f32x2 s = (v * v) * (-0.72134752044f);
    f32x2 e; e.x = __builtin_amdgcn_exp2f(s.x); e.y = __builtin_amdgcn_exp2f(s.y);
    const f32x2 m = v * (q * e), r = v - m;
    f32x2 o; o.x = v.x < 0.f ? m.x : r.x; o.y = v.y < 0.f ? m.y : r.y; return o;
}

template <int ACT  > struct EpiBf16 {
    static constexpr bool PERM = true, AFTER_DRAIN = false; static_assert(ACT == 0 || ACT == 1, "EpiBf16: ACT is 0 (none) or 1 (gelu_pk)");
    bf16_t* O; int ldc; const float* bias; int split_cols; size_t split_stride; float scale0;
    __device__ __forceinline__ void operator()(const f32x4 (&acc)[2][2][4][2], const Unit& u, int wr, int wc, int fr, int fq) const {
        const int row0 = u.pm * BM + wr * 64 + fr; int colt = u.pn * BM; bf16_t* base = O;
        float sc = 1.f; if (split_cols) { const int t = colt / split_cols; base += (size_t)t * split_stride; colt -= t * split_cols; if (t == 0) sc = scale0; }
        const int col0 = colt + wc * 32 + 8 * fq, bcol0 = u.pn * BM + wc * 32 + 8 * fq;
        f32x4 bv[2][2];
#pragma unroll
        for (int bj = 0; bj < 2; ++bj)
#pragma unroll
            for (int n = 0; n < 2; ++n) bv[bj][n] = bias ? *(const f32x4*)(bias + bcol0 + bj * HALF + 4 * n) : (f32x4){0.f, 0.f, 0.f, 0.f};
#pragma unroll
        for (int ai = 0; ai < 2; ++ai)
#pragma unroll
            for (int m = 0; m < 4; ++m) { bf16_t* rowp = base + (size_t)(row0 + ai * HALF + m * 16) * ldc + col0;
#pragma unroll
                for (int bj = 0; bj < 2; ++bj) { f32x4 v0 = acc[ai][bj][m][0] + bv[bj][0], v1 = acc[ai][bj][m][1] + bv[bj][1];
                    if (ACT == 1) { f32x2 a = gelu_pk((f32x2){v0[0], v0[1]}), b = gelu_pk((f32x2){v0[2], v0[3]}), c = gelu_pk((f32x2){v1[0], v1[1]}), d = gelu_pk((f32x2){v1[2], v1[3]});
                        v0 = (f32x4){a.x, a.y, b.x, b.y}; v1 = (f32x4){c.x, c.y, d.x, d.y}; }
                    v0 = v0 * sc; v1 = v1 * sc; u32x4 w; w.x = cvt_pk_bf16(v0[0], v0[1]); w.y = cvt_pk_bf16(v0[2], v0[3]); w.z = cvt_pk_bf16(v1[0], v1[1]); w.w = cvt_pk_bf16(v1[2], v1[3]);
                    *(u32x4*)(rowp + bj * HALF) = w; } }
    }
};

template <class Epi, class Sched, bool ALIGN_EPI = false, bool SP2 = false>
__device__ __forceinline__ void gemm_phase(PG8_LAS unsigned char* lds, const Gemm g, const Sched& S, const Epi& E, int wid0) {
    int tid_ = wid0 * 64 + (int)__builtin_amdgcn_mbcnt_hi(~0u, __builtin_amdgcn_mbcnt_lo(~0u, 0u)); asm volatile("" : "+v"(tid_));
    const int tid = tid_, wid = __builtin_amdgcn_readfirstlane(tid >> 6), lane = tid & 63, wr = wid >> 2, wc = wid & 3, fr = lane & 15, fq = lane >> 4;
    const int K = g.K, nt = K / BK;
    unsigned voffA[2], voffB[2];
#pragma unroll
    for (int i = 0; i < 2; ++i) { int R, C; stage_rc(tid * 16 + i * 8192, R, C); const int Rb = Epi::PERM ? ((R & ~31) + perm32(R & 31)) : R;
        voffA[i] = (unsigned)(R * K + C) * 2u; voffB[i] = (unsigned)(Rb * K + C) * 2u; }
    const size_t kstep = (size_t)(BK * 2);
    const size_t hstep = (size_t)HALF * K * 2;
    const size_t tstep = 2 * hstep;
    const unsigned ldsw = (unsigned)wid * 1024u;
    const int aoff = lds_byte(wr * 64 + fr, fq * 8), boff = lds_byte(wc * 32 + fr, fq * 8);
#define PG8_SA(b, h) (((b) * 2 + (h)) * HTB)
#define PG8_SB(b, h) ((4 + (b) * 2 + (h)) * HTB)
#define PG8_STAGE(bufoff, gbase, voff) do { _Pragma("unroll") for (int _i = 0; _i < 2; ++_i) \
        __builtin_amdgcn_global_load_lds((const unsigned*)((const char*)(gbase) + (voff)[_i]), (PG8_LAS unsigned*)(lds + (bufoff) + ldsw + _i * 8192), 16, 0, 0); } while (0)
#define PG8_LDA(dst, b, h) do { _Pragma("unroll") for (int m = 0; m < 4; ++m) _Pragma("unroll") for (int k = 0; k < 2; ++k) dst[m][k] = *(const PG8_LAS bf16x8*)(lds + PG8_SA(b, h) + aoff + m * 2048 + k * 1024); } while (0)
#define PG8_LDB(dst, b, h) do { _Pragma("unroll") for (int n = 0; n < 2; ++n) _Pragma("unroll") for (int k = 0; k < 2; ++k) dst[n][k] = *(const PG8_LAS bf16x8*)(lds + PG8_SB(b, h) + boff + n * 2048 + k * 1024); } while (0)
#define PG8_MMA(ai, bj, At, Bt) do { __builtin_amdgcn_s_setprio(1); _Pragma("unroll") for (int m = 0; m < 4; ++m) _Pragma("unroll") for (int n = 0; n < 2; ++n) _Pragma("unroll") for (int k = 0; k < 2; ++k) \
        acc[ai][bj][m][n] = __builtin_amdgcn_mfma_f32_16x16x32_bf16(Bt[n][k], At[m][k], acc[ai][bj][m][n], 0, 0, 0); __builtin_amdgcn_s_setprio(0); } while (0)
#define PG8_WAIT_V(n) asm volatile("s_waitcnt vmcnt(" #n ")" ::: "memory")
#define PG8_WAIT_L(n) asm volatile("s_waitcnt lgkmcnt(" #n ")" ::: "memory")
#define PG8_BAR __builtin_amdgcn_s_barrier()
#define PG8_SCHED __builtin_amdgcn_sched_barrier(0)
    Unit cur, nxt; int ui = 0;
    if (!S.next(0, cur)) return;
    f32x4 acc[2][2][4][2];
#pragma unroll
    for (int a = 0; a < 2; ++a)
#pragma unroll
        for (int b = 0; b < 2; ++b)
#pragma unroll
            for (int m = 0; m < 4; ++m)
#pragma unroll
                for (int n = 0; n < 2; ++n) acc[a][b][m][n] = (f32x4){0.f, 0.f, 0.f, 0.f};
    bf16x8 At[4][2], B0[2][2], B1[2][2];
    const char* cA = (const char*)g.A + (size_t)cur.pm * tstep; const char* cB = (const char*)g.Bt + (size_t)cur.pn * tstep;
    S.a_ready(cur);
    if constexpr (SP2) {
        PG8_STAGE(PG8_SB(0, 0), cB, voffB); PG8_STAGE(PG8_SB(0, 1), cB + hstep, voffB); PG8_STAGE(PG8_SA(0, 0), cA, voffA); PG8_STAGE(PG8_SA(0, 1), cA + hstep, voffA);
        if (wr == 1) PG8_BAR;
        PG8_WAIT_V(2); PG8_BAR;
        PG8_STAGE(PG8_SB(1, 0), cB + kstep, voffB); PG8_STAGE(PG8_SA(1, 0), cA + kstep, voffA); PG8_STAGE(PG8_SB(1, 1), cB + hstep + kstep, voffB);
        PG8_WAIT_V(6); PG8_BAR;
    } else {
        PG8_STAGE(PG8_SB(0, 0), cB, voffB); PG8_STAGE(PG8_SA(0, 0), cA, voffA); PG8_STAGE(PG8_SB(0, 1), cB + hstep, voffB); PG8_STAGE(PG8_SA(0, 1), cA + hstep, voffA);
        if (wr == 1) PG8_BAR;
        PG8_WAIT_V(4); PG8_BAR;
        PG8_STAGE(PG8_SB(1, 0), cB + kstep, voffB); PG8_STAGE(PG8_SA(1, 0), cA + kstep, voffA); PG8_STAGE(PG8_SB(1, 1), cB + hstep + kstep, voffB);
        PG8_WAIT_V(6); PG8_BAR;
    }
    for (;;) {
        const bool has_next = S.next(ui + 1, nxt);
        const char* nA = has_next ? (const char*)g.A + (size_t)nxt.pm * tstep : cA; const char* nB = has_next ? (const char*)g.Bt + (size_t)nxt.pn * tstep : cB;
        for (int t = 0; t < nt; t += 2) {
            const bool last = (t == nt - 2);
            const char* a1 = cA + (size_t)(t + 1) * kstep;
            const char* a2 = last ? nA : cA + (size_t)(t + 2) * kstep; const char* b2 = last ? nB : cB + (size_t)(t + 2) * kstep;
            const char* a3 = a2 + kstep; const char* b3 = b2 + kstep;
            if (last && has_next) S.a_ready(nxt);
            if constexpr (SP2) {
            PG8_LDB(B0, 0, 0); PG8_LDB(B1, 0, 1); PG8_SCHED; PG8_LDA(At, 0, 0); PG8_STAGE(PG8_SA(1, 1), a1 + hstep, voffA);
            PG8_WAIT_V(8); PG8_WAIT_L(0); PG8_BAR; PG8_MMA(0, 0, At, B0); PG8_MMA(0, 1, At, B1); PG8_BAR; PG8_SCHED;
            PG8_LDA(At, 0, 1); PG8_STAGE(PG8_SB(0, 0), b2, voffB); PG8_STAGE(PG8_SB(0, 1), b2 + hstep, voffB); PG8_STAGE(PG8_SA(0, 0), a2, voffA);
            PG8_WAIT_V(8); PG8_WAIT_L(0); PG8_BAR; PG8_MMA(1, 0, At, B0); PG8_MMA(1, 1, At, B1); PG8_BAR; PG8_SCHED;
            PG8_LDB(B0, 1, 0); PG8_LDB(B1, 1, 1); PG8_SCHED; PG8_LDA(At, 1, 0); PG8_STAGE(PG8_SA(0, 1), a2 + hstep, voffA);
            PG8_WAIT_V(8); PG8_WAIT_L(0); PG8_BAR; PG8_MMA(0, 0, At, B0); PG8_MMA(0, 1, At, B1); PG8_BAR; PG8_SCHED;
            PG8_LDA(At, 1, 1); PG8_STAGE(PG8_SB(1, 0), b3, voffB); PG8_STAGE(PG8_SB(1, 1), b3 + hstep, voffB); PG8_STAGE(PG8_SA(1, 0), a3, voffA);
            PG8_WAIT_V(8); PG8_WAIT_L(0); PG8_BAR; PG8_MMA(1, 0, At, B0); PG8_MMA(1, 1, At, B1); PG8_BAR; PG8_SCHED;
            } else {
            PG8_LDB(B0, 0, 0); PG8_SCHED; PG8_LDA(At, 0, 0); PG8_STAGE(PG8_SA(1, 1), a1 + hstep, voffA);
            PG8_WAIT_L(8); PG8_BAR; PG8_WAIT_L(0); PG8_MMA(0, 0, At, B0); PG8_BAR; PG8_SCHED;
            PG8_LDB(B1, 0, 1); PG8_STAGE(PG8_SB(0, 0), b2, voffB);
            PG8_BAR; PG8_WAIT_L(0); PG8_MMA(0, 1, At, B1); PG8_BAR;
            PG8_LDA(At, 0, 1); PG8_STAGE(PG8_SA(0, 0), a2, voffA);
            PG8_BAR; PG8_WAIT_L(0); PG8_MMA(1, 0, At, B0); PG8_BAR; PG8_SCHED;
            PG8_STAGE(PG8_SB(0, 1), b2 + hstep, voffB);
            PG8_WAIT_V(6); PG8_BAR; PG8_MMA(1, 1, At, B1); PG8_BAR;
            PG8_LDB(B0, 1, 0); PG8_SCHED; PG8_LDA(At, 1, 0); PG8_STAGE(PG8_SA(0, 1), a2 + hstep, voffA);
            PG8_WAIT_L(8); PG8_BAR; PG8_WAIT_L(0); PG8_MMA(0, 0, At, B0); PG8_BAR; PG8_SCHED;
            PG8_LDB(B1, 1, 1); PG8_STAGE(PG8_SB(1, 0), b3, voffB);
            PG8_BAR; PG8_WAIT_L(0); PG8_MMA(0, 1, At, B1); PG8_BAR;
            PG8_LDA(At, 1, 1); PG8_STAGE(PG8_SA(1, 0), a3, voffA);
            PG8_BAR; PG8_WAIT_L(0); PG8_MMA(1, 0, At, B0); PG8_BAR; PG8_SCHED;
            PG8_STAGE(PG8_SB(1, 1), b3 + hstep, voffB);
            PG8_WAIT_V(6); PG8_BAR; PG8_MMA(1, 1, At, B1); PG8_BAR;
            }
        }
        if constexpr (ALIGN_EPI) { if (wr == 0) PG8_BAR; }
        if constexpr (!Epi::AFTER_DRAIN) { E(acc, cur, wr, wc, fr, fq); S.done(cur); }
        if (!has_next) break;
#pragma unroll
        for (int a = 0; a < 2; ++a)
#pragma unroll
            for (int b = 0; b < 2; ++b)
#pragma unroll
                for (int m = 0; m < 4; ++m)
#pragma unroll
                    for (int n = 0; n < 2; ++n) acc[a][b][m][n] = (f32x4){0.f, 0.f, 0.f, 0.f};
        cur = nxt; cA = nA; cB = nB; ++ui;
        if constexpr (ALIGN_EPI) { if (wr == 1) PG8_BAR; }
    }
    PG8_WAIT_V(0);
    if constexpr (!ALIGN_EPI) { if (wr == 0) PG8_BAR; }
    PG8_BAR;
    if constexpr (Epi::AFTER_DRAIN) { E.fused(acc, cur, wr, wc, fr, fq, lds, wid, lane); S.done(cur); }
#undef PG8_SA
#undef PG8_SB
#undef PG8_STAGE
#undef PG8_LDA
#undef PG8_LDB
#undef PG8_MMA
#undef PG8_WAIT_V
#undef PG8_WAIT_L
#undef PG8_BAR
#undef PG8_SCHED
}
}
namespace pg8 {
struct EpiSwiGLU {
    static constexpr bool PERM = true, AFTER_DRAIN = false;
    bf16_t* O; int ldc;
    __device__ __forceinline__ void operator()(const f32x4 (&acc)[2][2][4][2], const Unit& u, int wr, int wc, int fr, int fq) const {
        const int row0 = u.pm * BM + wr * 64 + fr; const int col0 = u.pn * HALF + wc * 32 + 8 * fq;
#pragma unroll
        for (int ai = 0; ai < 2; ++ai)
#pragma unroll
            for (int m = 0; m < 4; ++m) { bf16_t* rowp = O + (size_t)(row0 + ai * HALF + m * 16) * ldc + col0;
                float hv[8];
#pragma unroll
                for (int n = 0; n < 2; ++n)
#pragma unroll
                    for (int e = 0; e < 4; ++e) { const float g = acc[ai][0][m][n][e], up = acc[ai][1][m][n][e];
                        const float ex = __builtin_amdgcn_exp2f(-g * 1.4426950408889634f);
                        hv[n * 4 + e] = g * __builtin_amdgcn_rcpf(1.0f + ex) * up; }
                u32x4 w; w.x = cvt_pk_bf16(hv[0], hv[1]); w.y = cvt_pk_bf16(hv[2], hv[3]); w.z = cvt_pk_bf16(hv[4], hv[5]); w.w = cvt_pk_bf16(hv[6], hv[7]);
                *(u32x4*)rowp = w; }
    }
};
struct EpiResid {
    static constexpr bool PERM = false, AFTER_DRAIN = false;
    const float* base; float* out; int ldc; float alpha;
    __device__ __forceinline__ void operator()(const f32x4 (&acc)[2][2][4][2], const Unit& u, int wr, int wc, int fr, int fq) const {
        const int col0 = u.pn * BM + wc * 32 + 4 * fq;
#pragma unroll
        for (int ai = 0; ai < 2; ++ai) {
            f32x4 bs[4][2][2];
#pragma unroll
            for (int m = 0; m < 4; ++m) { const size_t ro = (size_t)(u.pm * BM + ai * HALF + wr * 64 + m * 16 + fr) * ldc + col0;
#pragma unroll
                for (int bj = 0; bj < 2; ++bj)
#pragma unroll
                    for (int n = 0; n < 2; ++n) bs[m][bj][n] = *(const f32x4*)(base + ro + bj * HALF + n * 16); }
            asm volatile("" ::: "memory");
#pragma unroll
            for (int m = 0; m < 4; ++m) { const size_t ro = (size_t)(u.pm * BM + ai * HALF + wr * 64 + m * 16 + fr) * ldc + col0;
#pragma unroll
                for (int bj = 0; bj < 2; ++bj)
#pragma unroll
                    for (int n = 0; n < 2; ++n) *(f32x4*)(out + ro + bj * HALF + n * 16) = bs[m][bj][n] + acc[ai][bj][m][n] * alpha; }
            asm volatile("" ::: "memory");
        }
    }
};
}

namespace cg = cooperative_groups;
#define LAS __attribute__((address_space(3)))
#define DI __device__ __forceinline__
typedef unsigned short bf16_t;
typedef short bf16x8 __attribute__((ext_vector_type(8)));
typedef short s16x4 __attribute__((ext_vector_type(4)));
typedef float f32x4 __attribute__((ext_vector_type(4)));
typedef float f32x2 __attribute__((ext_vector_type(2)));
typedef float f32x16 __attribute__((ext_vector_type(16)));
typedef unsigned u32x4 __attribute__((ext_vector_type(4)));
typedef unsigned u32x2 __attribute__((ext_vector_type(2)));
typedef __bf16 bf16x2_t __attribute__((ext_vector_type(2)));

constexpr int BATCH = 8, SEQ = 2048, DM = 2048, DFF = 5632, INC = 6144, M = BATCH * SEQ;
constexpr float EPS = 1e-5f;
constexpr float LOG2E = 1.4426950408889634f;
constexpr float QSCALE = 0.08838834764831845f * LOG2E;
constexpr int NWAVES = 8, NTHREADS = 512;

constexpr size_t MiB = 1u << 20;
constexpr size_t WS_CTL = 0;
constexpr size_t WS_WGU1 = 1 * MiB, WS_WD1 = 45 * MiB, WS_WIN = 67 * MiB, WS_WOUT = 91 * MiB, WS_WGU2 = 99 * MiB, WS_WD2 = 143 * MiB;
constexpr size_t WS_XN = 166 * MiB;
constexpr size_t WS_BIG = 230 * MiB;
constexpr size_t WS_END = 422 * MiB;
constexpr int RING_BYTES = 131072, MISC_OFF = RING_BYTES, LDS_BYTES = RING_BYTES + 256;

DI unsigned cvtpk(float lo, float hi) { f32x2 v = {lo, hi}; bf16x2_t b = __builtin_convertvector(v, bf16x2_t); return __builtin_bit_cast(unsigned, b); }
DI float bf2f(unsigned short s) { return __uint_as_float((unsigned)s << 16); }
DI float shx(float v, int o, int lane) { return __int_as_float(__builtin_amdgcn_ds_bpermute((lane ^ o) << 2, __float_as_int(v))); }
DI float swap32(float v, int h) { auto rr = __builtin_amdgcn_permlane32_swap(__float_as_uint(v), __float_as_uint(v), false, false); return __uint_as_float(h ? rr[0] : rr[1]); }
DI float wave_sum(float v, int lane) {
#pragma unroll
    for (int o = 1; o < 64; o <<= 1) v += shx(v, o, lane);
    return v;
}
DI void block_sync() { asm volatile("s_waitcnt vmcnt(0) lgkmcnt(0)" ::: "memory"); __builtin_amdgcn_s_barrier(); asm volatile("" ::: "memory"); }

DI void transpose_item(const float* __restrict__ W, int K, int N, bf16_t* __restrict__ WT, int mode, int slo, int shi, float scale, LAS float* scr, int item, int lane) {
    asm volatile("" : "+v"(lane));
    const int nblk = N / 32, kb = item / nblk, nb = item % nblk, k0 = 64 * kb, n0 = 32 * nb;
#pragma unroll 8
    for (int i = 0; i < 32; ++i) { const int kk = 2 * i + (lane >> 5); scr[kk * 33 + (lane & 31)] = W[(size_t)(k0 + kk) * N + n0 + (lane & 31)]; }
    asm volatile("s_waitcnt lgkmcnt(0)" ::: "memory");
    const int c = lane & 7;
    const float sc = (n0 >= slo && n0 < shi) ? scale : 1.0f;
    const int rbase = mode == 0 ? n0 : ((n0 >> 7) * 256 + (n0 & 127) + (mode == 2 ? 128 : 0));
#pragma unroll
    for (int j = 0; j < 4; ++j) { const int n = (lane >> 3) + 8 * j; const LAS float* s = scr + (8 * c) * 33 + n;
        u32x4 o; o.x = cvtpk(s[0 * 33] * sc, s[1 * 33] * sc); o.y = cvtpk(s[2 * 33] * sc, s[3 * 33] * sc); o.z = cvtpk(s[4 * 33] * sc, s[5 * 33] * sc); o.w = cvtpk(s[6 * 33] * sc, s[7 * 33] * sc);
        *(u32x4*)(WT + (size_t)(rbase + n) * K + k0 + 8 * c) = o; }
    asm volatile("s_waitcnt lgkmcnt(0)" ::: "memory");
}

template <bool F32OUT> DI void rms_rows(const float* src, const float* __restrict__ gain, bf16_t* dstb, float* dstf, int gw, int NGW, int lane) {
    asm volatile("" : "+v"(lane));
    for (int m = gw; m < M; m += NGW) {
        const f32x4* xr = (const f32x4*)(src + (size_t)m * DM) + lane;
        f32x4 v[8]; float s = 0.f;
#pragma unroll
        for (int j = 0; j < 8; ++j) { v[j] = xr[64 * j]; s += (v[j].x * v[j].x + v[j].y * v[j].y) + (v[j].z * v[j].z + v[j].w * v[j].w); }
        const float rstd = 1.0f / sqrtf(wave_sum(s, lane) * (1.0f / DM) + EPS);
#pragma unroll
        for (int j = 0; j < 8; ++j) { const f32x4 g = ((const f32x4*)gain)[lane + 64 * j]; const f32x4 y = v[j] * rstd * g;
            if (F32OUT) ((f32x4*)(dstf + (size_t)m * DM))[lane + 64 * j] = y;
            else { u32x2 w; w.x = cvtpk(y.x, y.y); w.y = cvtpk(y.z, y.w); ((u32x2*)(dstb + (size_t)m * DM))[lane + 64 * j] = w; } }
    }
}

DI void qknorm_rows(bf16_t* U, const float* __restrict__ qn, const float* __restrict__ kn, int gw, int NGW, int lane) {
    asm volatile("" : "+v"(lane));
    const int cw = lane & 15;
    for (int m = gw; m < M; m += NGW) {
        const int pos = m & (SEQ - 1);
        float cs[8], sn[8];
        if (cw < 4) {
#pragma unroll
            for (int e = 0; e < 8; ++e) { const int fi = 8 * (cw & 1) + e;
                const float invf = exp2f(-(float)fi * (18.931568569324174f / 16.0f));
                const float ang = (float)pos * invf;
                double rv = (double)ang * 0.15915494309189535; rv -= __builtin_rint(rv); const float fr = (float)rv;
                cs[e] = __builtin_amdgcn_cosf(fr); sn[e] = __builtin_amdgcn_sinf(fr); }
        } else {
#pragma unroll
            for (int e = 0; e < 8; ++e) { cs[e] = 1.f; sn[e] = 0.f; }
        }
        bf16_t* urow = U + (size_t)m * INC;
        u32x4 raws[4];
#pragma unroll
        for (int j = 0; j < 4; ++j) raws[j] = ((const u32x4*)urow)[lane + 64 * j];
#pragma unroll
        for (int j = 0; j < 4; ++j) {
            const u32x4 raw = raws[j];
            float v[8];
#pragma unroll
            for (int e = 0; e < 4; ++e) { v[2 * e] = __uint_as_float(raw[e] << 16); v[2 * e + 1] = __uint_as_float(raw[e] & 0xffff0000u); }
            float ss = 0.f;
#pragma unroll
            for (int e = 0; e < 8; ++e) ss += v[e] * v[e];
            ss += shx(ss, 1, lane); ss += shx(ss, 2, lane); ss += shx(ss, 4, lane); ss += shx(ss, 8, lane);
            const float rstd = 1.0f / sqrtf(ss * (1.0f / 128.0f) + EPS);
            const float* gp = (j < 2 ? qn : kn) + 8 * cw;
            const f32x4 g0 = *(const f32x4*)gp, g1 = *(const f32x4*)(gp + 4);
            float y[8];
#pragma unroll
            for (int e = 0; e < 8; ++e) y[e] = v[e] * rstd * (e < 4 ? g0[e] : g1[e - 4]);
            const float sgn = (cw < 2) ? -1.f : 1.f;
#pragma unroll
            for (int e = 0; e < 8; ++e) { const float yp = shx(y[e], 2, lane); y[e] = y[e] * cs[e] + sgn * yp * sn[e]; }
            if (j < 2) {
#pragma unroll
                for (int e = 0; e < 8; ++e) y[e] *= QSCALE;
            }
            u32x4 w; w.x = cvtpk(y[0], y[1]); w.y = cvtpk(y[2], y[3]); w.z = cvtpk(y[4], y[5]); w.w = cvtpk(y[6], y[7]);
            ((u32x4*)urow)[lane + 64 * j] = w;
        }
    }
}

namespace att {
constexpr int ULD = INC, STAGE = 65536;
constexpr float NEG = -1e30f;
DI int crow(int i, int h) { return (i & 3) + 8 * (i >> 2) + 4 * h; }
DI void glds16(const void* g, LAS unsigned char* l) { __builtin_amdgcn_global_load_lds((const unsigned*)g, (LAS unsigned*)l, 16, 0, 0); }
template <int MODE> DI void load_tile128(const bf16_t* g, LAS unsigned char* dst, int wid, int lane) {
#pragma unroll
    for (int t = 0; t < 2; ++t) { const int ci = wid + 8 * t, R = 4 * ci + (lane >> 4), cp = lane & 15;
        const int c = MODE == 0 ? (cp ^ (R & 15)) : ((((cp >> 2) ^ (R & 3)) << 2) | (cp & 3));
        glds16(g + (size_t)R * ULD + c * 8, dst + ci * 1024); }
}
DI void load_tile256(const bf16_t* g, LAS unsigned char* dst, int wid, int lane) {
#pragma unroll
    for (int t = 0; t < 4; ++t) { const int ci = wid + 8 * t, R = 2 * ci + (lane >> 5), cp = lane & 31;
        const int c = (((cp >> 2) ^ (R & 3)) << 2) | (cp & 3);
        glds16(g + (size_t)R * ULD + c * 8, dst + ci * 1024); }
}
DI s16x4 vtr(const LAS unsigned char* p) { typedef short v4i16_t __attribute__((ext_vector_type(4))); return __builtin_bit_cast(s16x4, __builtin_amdgcn_ds_read_tr16_b64_v4i16((LAS v4i16_t*)p)); }
DI bf16x8 pack8(const f32x16& x, int s) {
    u32x4 p; p.x = cvtpk(x[8 * s], x[8 * s + 1]); p.y = cvtpk(x[8 * s + 2], x[8 * s + 3]); p.z = cvtpk(x[8 * s + 4], x[8 * s + 5]); p.w = cvtpk(x[8 * s + 6], x[8 * s + 7]);
    return __builtin_bit_cast(bf16x8, p);
}
#define MFMA32(a, b, c) __builtin_amdgcn_mfma_f32_32x32x16_bf16((a), (b), (c), 0, 0, 0)
DI void qk_tile(f32x16 (&sT)[2], const LAS unsigned char* kimg, const bf16x8 (&qf)[8], int r, int h) {
    const LAS unsigned char* kp = kimg + r * 256; const int sw = r & 15;
    bf16x8 kf[2][2][2];
#define QK_LOAD(bt) do { _Pragma("unroll") for (int s2 = 0; s2 < 2; ++s2) _Pragma("unroll") for (int kb = 0; kb < 2; ++kb) \
        kf[(bt) & 1][s2][kb] = *(const LAS bf16x8*)(kp + kb * 8192 + (((2 * (2 * (bt) + s2) + h) ^ sw) << 4)); } while (0)
    QK_LOAD(0);
    f32x16 a0 = {}, a1 = {};
#pragma unroll
    for (int bt = 0; bt < 4; ++bt) {
        if (bt + 1 < 4) QK_LOAD(bt + 1);
        __builtin_amdgcn_sched_barrier(0);
#pragma unroll
        for (int s2 = 0; s2 < 2; ++s2) { a0 = MFMA32(kf[bt & 1][s2][0], qf[2 * bt + s2], a0); a1 = MFMA32(kf[bt & 1][s2][1], qf[2 * bt + s2], a1); }
        __builtin_amdgcn_sched_barrier(0);
    }
#undef QK_LOAD
    sT[0] = a0; sT[1] = a1;
}
DI f32x16 qk_half_lq(const LAS unsigned char* kimg32, const LAS unsigned char* qimg, int r, int h) {
    const int sw = r & 15; const LAS unsigned char* kp = kimg32 + r * 256; const LAS unsigned char* qp = qimg + r * 256;
    bf16x8 kf[2][2], qv[2][2];
#define QK_LOAD(bt) do { _Pragma("unroll") for (int s2 = 0; s2 < 2; ++s2) { const int co = (((2 * (2 * (bt) + s2) + h) ^ sw) << 4); qv[(bt) & 1][s2] = *(const LAS bf16x8*)(qp + co); \
        kf[(bt) & 1][s2] = *(const LAS bf16x8*)(kp + co); } } while (0)
    QK_LOAD(0);
    f32x16 a0 = {};
#pragma unroll
    for (int bt = 0; bt < 4; ++bt) {
        if (bt + 1 < 4) QK_LOAD(bt + 1);
        __builtin_amdgcn_sched_barrier(0);
#pragma unroll
        for (int s2 = 0; s2 < 2; ++s2) a0 = MFMA32(kf[bt & 1][s2], qv[bt & 1][s2], a0);
        __builtin_amdgcn_sched_barrier(0);
    }
#undef QK_LOAD
    return a0;
}
template <int RB> DI void pv_half(f32x16 (&o)[4], const f32x16& x, const LAS unsigned char* vimg, int lane, int kb) {
    const int h = lane >> 5, half = (lane >> 4) & 1, q = (lane & 15) >> 2, p = lane & 3;
    const LAS unsigned char* vb = vimg + (32 * kb + 4 * h + q) * RB + 32 * half + 8 * p;
    s16x4 lo[2][4], hi[2][4];
#pragma unroll
    for (int db = 0; db < 4; ++db) { const LAS unsigned char* a = vb + ((db ^ q) << 6); lo[0][db] = vtr(a); hi[0][db] = vtr(a + 8 * RB); }
#pragma unroll
    for (int s = 0; s < 2; ++s) {
        const bf16x8 pf = pack8(x, s);
        if (s == 0) {
#pragma unroll
            for (int db = 0; db < 4; ++db) { const LAS unsigned char* a = vb + ((db ^ q) << 6) + 16 * RB; lo[1][db] = vtr(a); hi[1][db] = vtr(a + 8 * RB); }
        }
        __builtin_amdgcn_sched_barrier(0);
#pragma unroll
        for (int db = 0; db < 4; ++db) { const bf16x8 vf = __builtin_shufflevector(lo[s][db], hi[s][db], 0, 1, 2, 3, 4, 5, 6, 7); o[db] = MFMA32(vf, pf, o[db]); }
        __builtin_amdgcn_sched_barrier(0);
    }
}
template <int RB> DI void pv_tile(f32x16 (&o)[4], const f32x16 (&sT)[2], const LAS unsigned char* vimg, int lane, int db0) {
    const int h = lane >> 5, half = (lane >> 4) & 1, q = (lane & 15) >> 2, p = lane & 3;
    const LAS unsigned char* vb = vimg + (4 * h + q) * RB + 32 * half + 8 * p;
    const LAS unsigned char* va[4];
#pragma unroll
    for (int db = 0; db < 4; ++db) va[db] = vb + (((db0 + db) ^ q) << 6);
    s16x4 lo[2][4], hi[2][4];
#pragma unroll
    for (int db = 0; db < 4; ++db) { lo[0][db] = vtr(va[db]); hi[0][db] = vtr(va[db] + 8 * RB); }
#pragma unroll
    for (int s = 0; s < 4; ++s) {
        const bf16x8 pf = pack8(sT[s >> 1], s & 1);
        if (s + 1 < 4) {
#pragma unroll
            for (int db = 0; db < 4; ++db) { lo[(s + 1) & 1][db] = vtr(va[db] + 16 * (s + 1) * RB); hi[(s + 1) & 1][db] = vtr(va[db] + 16 * (s + 1) * RB + 8 * RB); }
        }
        __builtin_amdgcn_sched_barrier(0);
#pragma unroll
        for (int db = 0; db < 4; ++db) { const bf16x8 vf = __builtin_shufflevector(lo[s & 1][db], hi[s & 1][db], 0, 1, 2, 3, 4, 5, 6, 7); o[db] = MFMA32(vf, pf, o[db]); }
        __builtin_amdgcn_sched_barrier(0);
    }
}

DI f32x16 qk_half(const LAS unsigned char* kimg32, const bf16x8 (&qf)[8], int r, int h) {
    const int sw = r & 15; const LAS unsigned char* kp = kimg32 + r * 256;
    bf16x8 kf[8];
#pragma unroll
    for (int s = 0; s < 8; ++s) kf[s] = *(const LAS bf16x8*)(kp + (((2 * s + h) ^ sw) << 4));
    f32x16 a0 = {};
#pragma unroll
    for (int s = 0; s < 8; ++s) a0 = MFMA32(kf[s], qf[s], a0);
    return a0;
}
DI void diff_unit(int bh, int qb, const bf16_t* __restrict__ U, bf16_t* __restrict__ AO, const float* __restrict__ subln, float lam, LAS unsigned char* lds, int wid, int lane) {
    asm volatile("" : "+v"(lane));
    const int b = bh >> 2, hd = bh & 3, r = lane & 31, h = lane >> 5, pi = wid >> 2, map = (wid >> 1) & 1, dh = wid & 1;
    const int q0w = qb * 64 + 32 * pi;
    const size_t rowbase = (size_t)b * SEQ;
    bf16x8 qf[8];
    { const bf16_t* Qp = U + (rowbase + q0w + r) * ULD + map * 512 + hd * 128 + h * 8;
#pragma unroll
      for (int s = 0; s < 8; ++s) qf[s] = *(const bf16x8*)(Qp + 16 * s); }
    const int NB = 2 * qb + 2, mynb = 2 * qb + pi + 1;
    const bf16_t* Kg1 = U + rowbase * ULD + 1024 + hd * 128;
    const bf16_t* Vg = U + rowbase * ULD + 2048 + hd * 256;
    unsigned offK, offV0, offV1;
    { const int R = 4 * wid + (lane >> 4), cp = lane & 15; offK = (unsigned)(R * ULD + ((cp ^ (R & 15)) << 3)); }
    { const int cp = lane & 31; const int R0 = 2 * wid + (lane >> 5), R1 = R0 + 16;
      offV0 = (unsigned)(R0 * ULD + (((((cp >> 2) ^ (R0 & 3)) << 2) | (cp & 3)) << 3)); offV1 = (unsigned)(R1 * ULD + (((((cp >> 2) ^ (R1 & 3)) << 2) | (cp & 3)) << 3)); }
#define DIFF_PIECE(j, p) do { const int jj_ = (j) < 63 ? (j) : 63; const size_t ko = (size_t)(32 * jj_) * ULD; LAS unsigned char* sp_ = lds + ((j) & 3) * 32768 + wid * 1024; \
        if ((p) == 0) glds16(Kg1 + ko + offK, sp_); else if ((p) == 1) glds16(Kg1 + 512 + ko + offK, sp_ + 8192); else if ((p) == 2) glds16(Vg + ko + offV0, sp_ + 16384); else glds16(Vg + ko + offV1, sp_ + 24576); } while (0)
#define DIFF_ISSUE(j) do { DIFF_PIECE(j, 0); DIFF_PIECE(j, 1); DIFF_PIECE(j, 2); DIFF_PIECE(j, 3); } while (0)
#define DIFF_SYNC() asm volatile("s_waitcnt vmcnt(4) lgkmcnt(0)\n\ts_barrier" ::: "memory")
    f32x16 o[4];
#pragma unroll
    for (int d = 0; d < 4; ++d) o[d] = (f32x16){};
    float mrun = NEG, lrun = 0.f;
    DIFF_ISSUE(0); DIFF_ISSUE(1); DIFF_ISSUE(2);
    asm volatile("s_waitcnt vmcnt(0) lgkmcnt(0)\n\ts_barrier" ::: "memory");
    f32x16 scur = qk_half(lds + map * 8192, qf, r, h);
    const int hq = lane >> 5, half = (lane >> 4) & 1, vq = (lane & 15) >> 2, vp = lane & 3;
    const int voff = 16384 + (4 * hq + vq) * 512 + 32 * half + 8 * vp;
    const int ksw = r & 15;
#define DIFF_MAX() do { float mx = scur[0]; _Pragma("unroll") for (int i = 1; i < 16; ++i) mx = fmaxf(mx, scur[i]); mx = fmaxf(mx, swap32(mx, h)); const float mnew = fmaxf(mrun, mx); \
        if (__any(mnew > mrun)) { const float f = __builtin_amdgcn_exp2f(mrun - mnew); lrun *= f; _Pragma("unroll") for (int d = 0; d < 4; ++d) o[d] = o[d] * f; mrun = mnew; } } while (0)
#define DIFF_VREAD(j) do { const LAS unsigned char* vb = lds + ((j) & 3) * 32768 + voff; _Pragma("unroll") for (int s_ = 0; s_ < 2; ++s_) _Pragma("unroll") for (int db = 0; db < 4; ++db) { \
        const LAS unsigned char* a_ = vb + 16 * s_ * 512 + (((4 * dh + db) ^ vq) << 6); lo[s_][db] = vtr(a_); hi[s_][db] = vtr(a_ + 8 * 512); } } while (0)
#define DIFF_PV() do { _Pragma("unroll") for (int s_ = 0; s_ < 2; ++s_) { const bf16x8 pf = pack8(scur, s_); _Pragma("unroll") for (int db = 0; db < 4; ++db) { \
        const bf16x8 vf = __builtin_shufflevector(lo[s_][db], hi[s_][db], 0, 1, 2, 3, 4, 5, 6, 7); o[db] = MFMA32(vf, pf, o[db]); } } } while (0)
    int j = 0;
    for (; j < mynb - 1; ++j) {
        DIFF_MAX();
        DIFF_SYNC();
        bf16x8 kf[8]; s16x4 lo[2][4], hi[2][4];
        { const LAS unsigned char* kp = lds + ((j + 1) & 3) * 32768 + map * 8192 + r * 256;
#pragma unroll
          for (int s = 0; s < 8; ++s) kf[s] = *(const LAS bf16x8*)(kp + (((2 * s + h) ^ ksw) << 4)); }
        __builtin_amdgcn_sched_barrier(0);
        f32x16 sn = {}; float ps = 0.f;
        const LAS unsigned char* vbj = lds + (j & 3) * 32768 + voff;
#pragma unroll
        for (int s = 0; s < 8; ++s) {
            sn = MFMA32(kf[s], qf[s], sn);
            if (s < 4) {
#pragma unroll
                for (int s_ = 0; s_ < 2; ++s_) { const LAS unsigned char* a_ = vbj + 16 * s_ * 512 + (((4 * dh + s) ^ vq) << 6); lo[s_][s] = vtr(a_); hi[s_][s] = vtr(a_ + 8 * 512); }
            }
            if ((s & 1) == 0) DIFF_PIECE(j + 3, s >> 1);
            const float e0 = __builtin_amdgcn_exp2f(scur[2 * s] - mrun), e1 = __builtin_amdgcn_exp2f(scur[2 * s + 1] - mrun);
            scur[2 * s] = e0; scur[2 * s + 1] = e1; ps += e0 + e1;
            __builtin_amdgcn_sched_barrier(0);
        }
        lrun += ps;
        DIFF_PV();
        scur = sn;
    }
    {
#pragma unroll
        for (int i = 0; i < 16; ++i) if (crow(i, h) > r) scur[i] = NEG;
        DIFF_MAX();
        DIFF_SYNC();
        DIFF_ISSUE(j + 3);
        s16x4 lo[2][4], hi[2][4];
        DIFF_VREAD(j);
        float ps = 0.f;
#pragma unroll
        for (int i = 0; i < 16; ++i) { const float pe = __builtin_amdgcn_exp2f(scur[i] - mrun); scur[i] = pe; ps += pe; }
        lrun += ps;
        DIFF_PV();
        ++j;
    }
    for (; j < NB; ++j) { DIFF_SYNC(); DIFF_ISSUE(j + 3); }
#undef DIFF_MAX
#undef DIFF_VREAD
#undef DIFF_PV
#undef DIFF_SYNC
#undef DIFF_PIECE
#undef DIFF_ISSUE
    block_sync();
    const float ltot = lrun + swap32(lrun, h);
    LAS float* comb = (LAS float*)(lds + (pi * 2 + dh) * 16384) + lane;
    LAS float* ssb = (LAS float*)(lds + 65536);
    if (map == 1) {
        const float sc = lam / ltot;
#pragma unroll
        for (int d = 0; d < 4; ++d)
#pragma unroll
            for (int i = 0; i < 16; ++i) comb[(d * 16 + i) * 64] = o[d][i] * sc;
    }
    block_sync();
    if (map == 0) {
        const float sc = 1.0f / ltot; float ss = 0.f;
#pragma unroll
        for (int d = 0; d < 4; ++d)
#pragma unroll
            for (int i = 0; i < 16; ++i) { const float v = o[d][i] * sc - comb[(d * 16 + i) * 64]; o[d][i] = v; ss += v * v; }
        ss += swap32(ss, h);
        if (h == 0) ssb[(pi * 2 + dh) * 32 + r] = ss;
    }
    block_sync();
    if (map == 0) {
        const float ss = ssb[(pi * 2) * 32 + r] + ssb[(pi * 2 + 1) * 32 + r];
        const float rstd = 0.8f / sqrtf(ss * (1.0f / 256.0f) + EPS);
        bf16_t* orow = AO + (rowbase + q0w + r) * DM + hd * 256 + dh * 128 + 4 * h;
        const float* gp = subln + dh * 128 + 4 * h;
#pragma unroll
        for (int d = 0; d < 4; ++d)
#pragma unroll
            for (int g = 0; g < 4; ++g) { const f32x4 gv = *(const f32x4*)(gp + 32 * d + 8 * g);
                u32x2 w; w.x = cvtpk(o[d][4 * g] * rstd * gv.x, o[d][4 * g + 1] * rstd * gv.y); w.y = cvtpk(o[d][4 * g + 2] * rstd * gv.z, o[d][4 * g + 3] * rstd * gv.w);
                *(u32x2*)(orow + 32 * d + 8 * g) = w; }
    }
    asm volatile("s_waitcnt lgkmcnt(0)" ::: "memory"); __builtin_amdgcn_s_barrier(); asm volatile("" ::: "memory");
}

template <bool MASKED> DI void sb_weights(f32x16& x, float& base, int kbase  , int qg, int h) {
    float L[16];
#pragma unroll
    for (int i = 0; i < 16; ++i) { const float z = x[i]; const float e = __builtin_amdgcn_exp2f(-fabsf(z));
        float l2 = -(fmaxf(z, 0.f) + __builtin_amdgcn_logf(1.0f + e));
        if (MASKED) { const int kg = kbase + crow(i, h); if (!(kg < qg)) l2 = 0.f; }
        L[i] = l2; if ((i & 7) == 7) __builtin_amdgcn_sched_barrier(0); }
    float T[4], To[4];
#pragma unroll
    for (int g = 0; g < 4; ++g) { L[4 * g + 2] += L[4 * g + 3]; L[4 * g + 1] += L[4 * g + 2]; L[4 * g] += L[4 * g + 1]; T[g] = L[4 * g]; To[g] = swap32(T[g], h); }
    float off[4]; float suf = 0.f;
#pragma unroll
    for (int g = 3; g >= 0; --g) { off[g] = suf + (h == 0 ? To[g] : 0.f); suf += T[g] + To[g]; }
#pragma unroll
    for (int i = 0; i < 16; ++i) { const float c = L[i] + off[i >> 2] + base; float a = __builtin_amdgcn_exp2f(x[i] + c);
        if (MASKED) { const int kg = kbase + crow(i, h); if (!(kg < qg)) a = 0.f; }
        x[i] = a; if ((i & 7) == 7) __builtin_amdgcn_sched_barrier(0); }
    base += suf;
}
constexpr float SB_CUT = 48.0f;
DI void sb_unit(int bh, int qb, const bf16_t* __restrict__ U, bf16_t* __restrict__ AO, LAS unsigned char* lds, int wid, int lane) {
    asm volatile("" : "+v"(lane));
    const int b = bh >> 3, hd = bh & 7, r = lane & 31, h = lane >> 5;
    const int q0w = qb * 256 + 32 * wid;
    const size_t rowbase = (size_t)b * SEQ;
    LAS unsigned char* qimg = lds + (wid < 4 ? 32768 + wid * 8192 : 98304 + (wid - 4) * 8192);
    { const bf16_t* Qp = U + (rowbase + q0w) * ULD + 3072 + hd * 128;
#pragma unroll
      for (int t = 0; t < 8; ++t) { const int Rr = 4 * t + (lane >> 4), cp = lane & 15; glds16(Qp + (size_t)Rr * ULD + ((cp ^ (Rr & 15)) << 3), qimg + t * 1024); } }
    const bf16_t* Kg = U + rowbase * ULD + 4096 + hd * 128;
    const bf16_t* Vg = U + rowbase * ULD + 5120 + hd * 128;
    const int NT = 4 * qb + 4;
    volatile LAS int* flags = (volatile LAS int*)(lds + MISC_OFF + 64);
    f32x16 o[4];
#pragma unroll
    for (int d = 0; d < 4; ++d) o[d] = (f32x16){};
    float R = 0.f;
#define SB_ISSUE(kt, st) do { const size_t ko = (size_t)(64 * (kt)) * ULD; LAS unsigned char* sp = lds + (st) * STAGE; \
        load_tile128<0>(Kg + ko, sp, wid, lane); load_tile128<1>(Vg + ko, sp + 16384, wid, lane); } while (0)
    SB_ISSUE(NT - 1, 0);
    const int qg = q0w + r;
    for (int ti = 0; ti < NT; ++ti) {
        const int kt = NT - 1 - ti;
        block_sync();
        if (ti > 0) { int alld = 1;
#pragma unroll
            for (int w = 0; w < 8; ++w) alld &= flags[((ti - 1) & 1) * 8 + w];
            if (alld) break; }
        if (ti + 1 < NT) SB_ISSUE(kt - 1, (ti + 1) & 1);
        int mydone = 0;
        if (64 * kt < q0w + 31) {
            if (!__all(R < -SB_CUT)) {
                const LAS unsigned char* sp = lds + (ti & 1) * STAGE;
                const bool masked = !(64 * kt + 63 < q0w);
#pragma unroll
                for (int kb = 1; kb >= 0; --kb) {
                    f32x16 x = qk_half_lq(sp + kb * 8192, qimg, r, h);
                    if (masked) sb_weights<true>(x, R, 64 * kt + 32 * kb, qg, h); else sb_weights<false>(x, R, 64 * kt + 32 * kb, qg, h);
                    pv_half<256>(o, x, sp + 16384, lane, kb);
                }
            }
            mydone = __all(R < -SB_CUT) ? 1 : 0;
        }
        if (lane == 0) flags[(ti & 1) * 8 + wid] = mydone;
    }
#undef SB_ISSUE
    bf16_t* orow = AO + (rowbase + q0w + r) * DM + 1024 + hd * 128 + 4 * h;
#pragma unroll
    for (int d = 0; d < 4; ++d)
#pragma unroll
        for (int g = 0; g < 4; ++g) { u32x2 w; w.x = cvtpk(o[d][4 * g], o[d][4 * g + 1]); w.y = cvtpk(o[d][4 * g + 2], o[d][4 * g + 3]); *(u32x2*)(orow + 32 * d + 8 * g) = w; }
    block_sync();
}
}

#define XB_TMO      128
#define XB_XCNT(j)  (256  + 64 * (j))
#define XB_XSUB(j)  (1280 + 64 * (j))
#define XB_XGEN(j)  (2304 + 64 * (j))
#define XB_TOP      3328
#define XB_TOPGEN   3392
#define XCD_BAR_WORDS 3456
#define XB_SPIN_CAP (1u << 18)

__device__ __forceinline__ unsigned xb_ld(unsigned* p)              { return __hip_atomic_load(p, __ATOMIC_RELAXED, __HIP_MEMORY_SCOPE_AGENT); }
__device__ __forceinline__ unsigned xb_add(unsigned* p, unsigned v) { return __hip_atomic_fetch_add(p, v, __ATOMIC_RELAXED, __HIP_MEMORY_SCOPE_AGENT); }
__device__ __forceinline__ unsigned xb_xcc_id() { return (unsigned)__builtin_amdgcn_s_getreg((3 << 11) | 20) & 0xFu; }
#define XB_SPIN(cond, bar) do { unsigned _sp = 0; while (cond) { __builtin_amdgcn_s_sleep(1); \
    if ((++_sp & 255u) == 0u) { if (xb_ld(&(bar)[XB_TMO])) break; if (_sp > XB_SPIN_CAP) { atomicAdd(&(bar)[XB_TMO], 1u); break; } } } } while (0)

struct XcdBarrier {
    unsigned* bar; unsigned x;
    volatile LAS unsigned* st;
};

__device__ __forceinline__ XcdBarrier xcd_barrier_post(unsigned* bar, volatile LAS unsigned* st) {
    XcdBarrier b; b.bar = bar; b.x = xb_xcc_id(); b.st = st;
    if (threadIdx.x == 0) (void)xb_add(&bar[XB_XCNT(b.x)], 1u);
    return b;
}
__device__ __forceinline__ void xcd_barrier_complete(unsigned* bar, unsigned x, unsigned& nloc, unsigned& nx) {
    const unsigned G = gridDim.x * gridDim.y * gridDim.z;
    unsigned sum, cnt, mine, sp = 0u;
    for (;;) {
        sum = 0u; cnt = 0u; mine = 0u;
#pragma unroll
        for (unsigned j = 0; j < 16; ++j) { const unsigned c = xb_ld(&bar[XB_XCNT(j)]); sum += c; cnt += (c > 0u) ? 1u : 0u; mine = (j == x) ? c : mine; }
        if (sum == G) break;
        __builtin_amdgcn_s_sleep(1);
        if ((++sp & 255u) == 0u) { if (xb_ld(&bar[XB_TMO])) break; if (sp > XB_SPIN_CAP) { atomicAdd(&bar[XB_TMO], 1u); break; } }
    }
    nloc = mine > 0u ? mine : 1u; nx = cnt > 0u ? cnt : 1u;
}

__device__ __forceinline__ void xcd_barrier(const XcdBarrier& b) {
    asm volatile("s_waitcnt vmcnt(0)" ::: "memory");
    __syncthreads();
    if (threadIdx.x == 0) {
        unsigned* bar = b.bar;
        __builtin_amdgcn_s_waitcnt(0);
        unsigned nloc = b.st[0], nx = b.st[1];
        if (nloc == 0u) { xcd_barrier_complete(bar, b.x, nloc, nx); b.st[0] = nloc; b.st[1] = nx; }
        const unsigned old = xb_add(&bar[XB_XSUB(b.x)], 1u);
        const unsigned gen = old / nloc;
        if (old + 1u == (gen + 1u) * nloc) {
            __builtin_amdgcn_fence(__ATOMIC_RELEASE, "agent");
            asm volatile("s_waitcnt vmcnt(0)" ::: "memory");
            const unsigned og = xb_add(&bar[XB_TOP], 1u);
            const unsigned tg = og / nx;
            if (og + 1u == (tg + 1u) * nx) xb_add(&bar[XB_TOPGEN], 1u);
            else XB_SPIN(xb_ld(&bar[XB_TOPGEN]) == tg, bar);
            __builtin_amdgcn_fence(__ATOMIC_ACQUIRE, "agent");
            xb_add(&bar[XB_XGEN(b.x)], 1u);
            asm volatile("s_waitcnt vmcnt(0)" ::: "memory");
        } else {
            XB_SPIN(xb_ld(&bar[XB_XGEN(b.x)]) == gen, bar);
            __builtin_amdgcn_fence(__ATOMIC_ACQUIRE, "agent");
            asm volatile("s_waitcnt vmcnt(0)" ::: "memory");
        }
    }
    __syncthreads();
}

struct Args { const float* in[20]; float* out; unsigned char* ws; };
enum { I_X = 0, I_N1, I_G1, I_U1, I_D1, I_NM, I_WIN, I_QN, I_KN, I_LQ1, I_LK1, I_LQ2, I_LK2, I_SUBLN, I_WOUT, I_N2, I_G2, I_U2, I_D2, I_NF };

__global__ void __launch_bounds__(NTHREADS, 2) fwd_megakernel(Args a) {
    extern __shared__ __attribute__((aligned(16))) unsigned char lds_raw[];
    LAS unsigned char* lds = (LAS unsigned char*)lds_raw;
    cg::grid_group grid = cg::this_grid();
    { volatile LAS unsigned* st0 = (volatile LAS unsigned*)(lds + MISC_OFF + 128); if (threadIdx.x == 0) { st0[0] = 0u; st0[1] = 0u; } __syncthreads(); }
    if (blockIdx.x == 0) for (int i = threadIdx.x; i < 16384; i += NTHREADS) ((unsigned*)(a.ws + WS_CTL))[i] = 0u;
#define GRID_BAR() xcd_barrier(xbar)
    const int G = gridDim.x, NGW = G * NWAVES;
    const int wid0 = __builtin_amdgcn_readfirstlane((int)threadIdx.x >> 6);
#define PHASE_IDS int lane = (int)__builtin_amdgcn_mbcnt_hi(~0u, __builtin_amdgcn_mbcnt_lo(~0u, 0u)); asm volatile("" : "+v"(lane)); const int wid = wid0, tid = wid * 64 + lane, gw = blockIdx.x * NWAVES + wid; (void)gw; (void)tid;
    unsigned char* ws = a.ws;
    unsigned* ctl = (unsigned*)(ws + WS_CTL);
    bf16_t* Wgu1 = (bf16_t*)(ws + WS_WGU1); bf16_t* Wd1 = (bf16_t*)(ws + WS_WD1); bf16_t* Win = (bf16_t*)(ws + WS_WIN); bf16_t* Wout = (bf16_t*)(ws + WS_WOUT);
    bf16_t* Wgu2 = (bf16_t*)(ws + WS_WGU2); bf16_t* Wd2 = (bf16_t*)(ws + WS_WD2);
    bf16_t* XN = (bf16_t*)(ws + WS_XN); bf16_t* BIG = (bf16_t*)(ws + WS_BIG);
    float* X = a.out;

    {
        PHASE_IDS
        LAS float* scr = (LAS float*)(lds + wid * 16384);
        constexpr int I_FF = (DM / 64) * (DFF / 32), I_DN = (DFF / 64) * (DM / 32), I_IN = (DM / 64) * (INC / 32), I_OUT = (DM / 64) * (DM / 32);
        constexpr int NITEMS = 4 * I_FF + 2 * I_DN + I_IN + I_OUT;
        for (int it = gw; it < NITEMS; it += NGW) {
            int r = it;
            if (r < I_FF) { transpose_item(a.in[I_G1], DM, DFF, Wgu1, 1, 0, 0, 1.f, scr, r, lane); continue; } r -= I_FF;
            if (r < I_FF) { transpose_item(a.in[I_U1], DM, DFF, Wgu1, 2, 0, 0, 1.f, scr, r, lane); continue; } r -= I_FF;
            if (r < I_DN) { transpose_item(a.in[I_D1], DFF, DM, Wd1, 0, 0, 0, 1.f, scr, r, lane); continue; } r -= I_DN;
            if (r < I_IN) { transpose_item(a.in[I_WIN], DM, INC, Win, 0, 3072, 4096, QSCALE, scr, r, lane); continue; } r -= I_IN;
            if (r < I_OUT) { transpose_item(a.in[I_WOUT], DM, DM, Wout, 0, 0, 0, 1.f, scr, r, lane); continue; } r -= I_OUT;
            if (r < I_FF) { transpose_item(a.in[I_G2], DM, DFF, Wgu2, 1, 0, 0, 1.f, scr, r, lane); continue; } r -= I_FF;
            if (r < I_FF) { transpose_item(a.in[I_U2], DM, DFF, Wgu2, 2, 0, 0, 1.f, scr, r, lane); continue; } r -= I_FF;
            transpose_item(a.in[I_D2], DFF, DM, Wd2, 0, 0, 0, 1.f, scr, r, lane);
        }
        rms_rows<false>(a.in[I_X], a.in[I_N1], XN, nullptr, gw, NGW, lane);
    }
    grid.sync();
    const XcdBarrier xbar = xcd_barrier_post((unsigned*)(a.ws + WS_CTL) + 4096, (volatile LAS unsigned*)(lds + MISC_OFF + 128));
    { pg8::Gemm g{XN, Wgu1, M, 2 * DFF, DM}; pg8::StaticOrder S; S.init(M, 2 * DFF, G, (int)blockIdx.x); pg8::EpiSwiGLU E{BIG, DFF};
      pg8::gemm_phase<pg8::EpiSwiGLU, pg8::StaticOrder, true, true>(lds, g, S, E, wid0); }
    GRID_BAR();
    { pg8::Gemm g{BIG, Wd1, M, DM, DFF}; pg8::StaticOrder S; S.init(M, DM, G, (int)blockIdx.x); pg8::EpiResid E{a.in[I_X], X, DM, 0.5f};
      pg8::gemm_phase<pg8::EpiResid, pg8::StaticOrder, true, true>(lds, g, S, E, wid0); }
    GRID_BAR();
    { PHASE_IDS rms_rows<false>(X, a.in[I_NM], XN, nullptr, gw, NGW, lane); }
    GRID_BAR();
    { pg8::Gemm g{XN, Win, M, INC, DM}; pg8::StaticOrder S; S.init(M, INC, G, (int)blockIdx.x); pg8::EpiBf16<0> E{BIG, INC, nullptr, 0, 0, 1.f};
      pg8::gemm_phase<pg8::EpiBf16<0>, pg8::StaticOrder, true, true>(lds, g, S, E, wid0); }
    GRID_BAR();
    { PHASE_IDS qknorm_rows(BIG, a.in[I_QN], a.in[I_KN], gw, NGW, lane); }
    GRID_BAR();
    {
        PHASE_IDS
        float lam;
        { const float p1 = a.in[I_LQ1][lane] * a.in[I_LK1][lane] + a.in[I_LQ1][lane + 64] * a.in[I_LK1][lane + 64];
          const float p2 = a.in[I_LQ2][lane] * a.in[I_LK2][lane] + a.in[I_LQ2][lane + 64] * a.in[I_LK2][lane + 64];
          lam = expf(wave_sum(p1, lane)) - expf(wave_sum(p2, lane)) + 0.2f; }
        volatile LAS int* sh = (volatile LAS int*)(lds + MISC_OFF);
        const int myx = (int)(__builtin_amdgcn_s_getreg((3 << 11) | 20) & 7u);
        for (int k = 0; k < 8; ++k) {
            const int qx = (myx + k) & 7; unsigned* cnt = ctl + 64 * (1 + qx);
            if (k == 1) { if (tid < 8) sh[8 + tid] = (int)__hip_atomic_load(ctl + 64 * (1 + tid), __ATOMIC_RELAXED, __HIP_MEMORY_SCOPE_AGENT); block_sync(); }
            if (k > 0 && sh[8 + qx] >= 128) continue;
            for (;;) {
                if (tid == 0) sh[0] = (int)atomicAdd(cnt, 1u);
                block_sync();
                const int idx = sh[0];
                block_sync();
                if (idx >= 128) break;
#ifndef NO_DIFF
                if (idx < 64) { const int sl = idx & 31, dbh = qx * 4 + 2 * (idx >> 5) + (sl >> 4), qi = sl & 15;
                    for (int rep = 0; rep < 2; ++rep) att::diff_unit(dbh, rep ? 31 - qi : qi, BIG, XN, a.in[I_SUBLN], lam, lds, wid, lane); }
#endif
#ifndef NO_SB
                if (idx >= 64) att::sb_unit(qx * 8 + ((idx - 64) >> 3), 7 - ((idx - 64) & 7), BIG, XN, lds, wid, lane);
#endif
            }
        }
    }
    GRID_BAR();
    { pg8::Gemm g{XN, Wout, M, DM, DM}; pg8::StaticOrder S; S.init(M, DM, G, (int)blockIdx.x); pg8::EpiResid E{X, X, DM, 1.0f};
      pg8::gemm_phase<pg8::EpiResid, pg8::StaticOrder, true, true>(lds, g, S, E, wid0); }
    GRID_BAR();
    { PHASE_IDS rms_rows<false>(X, a.in[I_N2], XN, nullptr, gw, NGW, lane); }
    GRID_BAR();
    { pg8::Gemm g{XN, Wgu2, M, 2 * DFF, DM}; pg8::StaticOrder S; S.init(M, 2 * DFF, G, (int)blockIdx.x); pg8::EpiSwiGLU E{BIG, DFF};
      pg8::gemm_phase<pg8::EpiSwiGLU, pg8::StaticOrder, true, true>(lds, g, S, E, wid0); }
    GRID_BAR();
    { pg8::Gemm g{BIG, Wd2, M, DM, DFF}; pg8::StaticOrder S; S.init(M, DM, G, (int)blockIdx.x); pg8::EpiResid E{X, X, DM, 0.5f};
      pg8::gemm_phase<pg8::EpiResid, pg8::StaticOrder, true, true>(lds, g, S, E, wid0); }
    GRID_BAR();
    { PHASE_IDS rms_rows<true>(X, a.in[I_NF], nullptr, X, gw, NGW, lane); }
}

extern "C" void kernel_launch(void* const* d_in, const int* in_sizes, int n_in, void* d_out, int out_size, void* d_ws, size_t ws_size, hipStream_t stream) {
    static int grid = 0;
    if (grid == 0) {
        if (n_in != 20 || out_size != M * DM || ws_size < WS_END) { fprintf(stderr, "kernel_launch: unexpected problem (n_in %d out %d ws %zu)\n", n_in, out_size, ws_size); grid = -1; return; }
        int dev = 0, cus = 0, per_cu = 0;
        (void)hipGetDevice(&dev); (void)hipDeviceGetAttribute(&cus, hipDeviceAttributeMultiprocessorCount, dev);
        (void)hipFuncSetAttribute((const void*)fwd_megakernel, hipFuncAttributeMaxDynamicSharedMemorySize, LDS_BYTES);
        (void)hipOccupancyMaxActiveBlocksPerMultiprocessor(&per_cu, (const void*)fwd_megakernel, NTHREADS, LDS_BYTES);
        if (per_cu < 1) { fprintf(stderr, "kernel_launch: occupancy query says %d blocks per CU\n", per_cu); per_cu = 1; }
        grid = cus * 1;
        (void)hipGetLastError();
    }
    if (grid < 0) return;
    Args a{};
    for (int i = 0; i < 20; ++i) a.in[i] = (const float*)d_in[i];
    a.out = (float*)d_out; a.ws = (unsigned char*)d_ws;
    void* args[] = {&a};
    hipError_t e = hipLaunchCooperativeKernel((const void*)fwd_megakernel, dim3(grid), dim3(NTHREADS), args, LDS_BYTES, stream);
    if (e != hipSuccess) fprintf(stderr, "cooperative launch failed: %s (grid %d)\n", hipGetErrorString(e), grid);
}
```

```cpp
#include <hip/hip_cooperative_groups.h>
#include <hip/hip_runtime.h>
#include <cstdio>
#include <cstdint>
namespace pg8 {
#define PG8_LAS __attribute__((address_space(3)))
typedef unsigned short bf16_t;
typedef short bf16x8 __attribute__((ext_vector_type(8)));
typedef float f32x4 __attribute__((ext_vector_type(4)));
typedef unsigned u32x4 __attribute__((ext_vector_type(4)));
constexpr int BM = 256, BK = 64, HALF = 128, HTB = HALF * BK * 2  , STAGE_BYTES = 8 * HTB, NXCD = 8, WGM = 8;

__host__ __device__ __forceinline__ int lds_byte(int r, int c) { const int st = (r >> 4) * 2 + (c >> 5), rr = r & 15, cc = c & 31, ob = rr * 64 + cc * 2; return st * 1024 + (ob ^ (((ob >> 9) & 1) << 5)); }
__host__ __device__ __forceinline__ void stage_rc(int b, int& R, int& C) { const int st = b / 1024, sb = b % 1024, swz = sb ^ (((sb >> 9) & 1) << 5); R = (st >> 1) * 16 + swz / 64; C = (st & 1) * 32 + (swz % 64) / 2; }
__host__ __device__ __forceinline__ int perm32(int rho) { const int n = rho >> 4, i = rho & 15; return 8 * (i >> 2) + 4 * n + (i & 3); }

struct Unit { int pm, pn; };
struct Gemm { const bf16_t* A; const bf16_t* Bt; int M, N, K; };

struct StaticOrder {
    int nM, nN, nwg, G, c;
    __host__ __device__ void init(int M, int N, int G_, int c_) { nM = M / BM; nN = N / BM; nwg = nM * nN; G = G_; c = c_; }
    __host__ __device__ bool next(int i, Unit& u) const {
        const long L = (long)i * G + c; if (L >= nwg) return false;
        int wgid = (int)L; { const int q = nwg / NXCD, r = nwg % NXCD, xcd = wgid % NXCD, off = wgid / NXCD; wgid = (xcd < r ? xcd * (q + 1) : r * (q + 1) + (xcd - r) * q) + off; }
        const int nig = WGM * nN, gid = wgid / nig, fm = gid * WGM, gsz = (nM - fm) < WGM ? (nM - fm) : WGM;
        u.pm = fm + ((wgid % nig) % gsz); u.pn = (wgid % nig) / gsz; return true;
    }
    __device__ __forceinline__ void a_ready(const Unit&) const {}
    __device__ __forceinline__ void done(const Unit&) const {}
};

__device__ __forceinline__ unsigned cvt_pk_bf16(float lo, float hi) { unsigned r; asm volatile("v_cvt_pk_bf16_f32 %0, %1, %2" : "=v"(r) : "v"(lo), "v"(hi)); return r; }
typedef float f32x2 __attribute__((ext_vector_type(2)));
__device__ __forceinline__ f32x2 gelu_pk(f32x2 v) {
    const f32x2 av = __builtin_elementwise_abs(v), d = av * 0.2316418882f + 1.0f;
    f32x2 t; t.x = __builtin_amdgcn_rcpf(d.x); t.y = __builtin_amdgcn_rcpf(d.y);
    f32x2 q = t * 0.5307027145f + (-0.7265760135f); q = q * t + 0.7107068705f; q = q * t + (-0.142248368f); q = q * t + 0.127414796f; q = q * t;
    const f32x2 s = (v * v) * (-0.72134752044f);
    f32x2 e; e.x = __builtin_amdgcn_exp2f(s.x); e.y = __builtin_amdgcn_exp2f(s.y);
    const f32x2 m = v * (q * e), r = v - m;
    f32x2 o; o.x = v.x < 0.f ? m.x : r.x; o.y = v.y < 0.f ? m.y : r.y; return o;
}

template <int ACT  > struct EpiBf16 {
    static constexpr bool PERM = true, AFTER_DRAIN = false; static_assert(ACT == 0 || ACT == 1, "EpiBf16: ACT is 0 (none) or 1 (gelu_pk)");
    bf16_t* O; int ldc; const float* bias; int split_cols; size_t split_stride; float scale0;
    __device__ __forceinline__ void operator()(const f32x4 (&acc)[2][2][4][2], const Unit& u, int wr, int wc, int fr, int fq) const {
        const int row0 = u.pm * BM + wr * 64 + fr; int colt = u.pn * BM; bf16_t* base = O;
        float sc = 1.f; if (split_cols) { const int t = colt / split_cols; base += (size_t)t * split_stride; colt -= t * split_cols; if (t == 0) sc = scale0; }
        const int col0 = colt + wc * 32 + 8 * fq, bcol0 = u.pn * BM + wc * 32 + 8 * fq;
        f32x4 bv[2][2];
#pragma unroll
        for (int bj = 0; bj < 2; ++bj)
#pragma unroll
            for (int n = 0; n < 2; ++n) bv[bj][n] = bias ? *(const f32x4*)(bias + bcol0 + bj * HALF + 4 * n) : (f32x4){0.f, 0.f, 0.f, 0.f};
#pragma unroll
        for (int ai = 0; ai < 2; ++ai)
#pragma unroll
            for (int m = 0; m < 4; ++m) { bf16_t* rowp = base + (size_t)(row0 + ai * HALF + m * 16) * ldc + col0;
#pragma unroll
                for (int bj = 0; bj < 2; ++bj) { f32x4 v0 = acc[ai][bj][m][0] + bv[bj][0], v1 = acc[ai][bj][m][1] + bv[bj][1];
                    if (ACT == 1) { f32x2 a = gelu_pk((f32x2){v0[0], v0[1]}), b = gelu_pk((f32x2){v0[2], v0[3]}), c = gelu_pk((f32x2){v1[0], v1[1]}), d = gelu_pk((f32x2){v1[2], v1[3]});
                        v0 = (f32x4){a.x, a.y, b.x, b.y}; v1 = (f32x4){c.x, c.y, d.x, d.y}; }
                    v0 = v0 * sc; v1 = v1 * sc; u32x4 w; w.x = cvt_pk_bf16(v0[0], v0[1]); w.y = cvt_pk_bf16(v0[2], v0[3]); w.z = cvt_pk_bf16(v1[0], v1[1]); w.w = cvt_pk_bf16(v1[2], v1[3]);
                    *(u32x4*)(rowp + bj * HALF) = w; } }
    }
};

template <class Epi, class Sched, bool ALIGN_EPI = false, bool SP2 = false>
__device__ __forceinline__ void gemm_phase(PG8_LAS unsigned char* lds, const Gemm g, const Sched S, const Epi E, int wid0) {
    int tid_ = wid0 * 64 + (int)__builtin_amdgcn_mbcnt_hi(~0u, __builtin_amdgcn_mbcnt_lo(~0u, 0u)); asm volatile("" : "+v"(tid_));
    const int tid = tid_, wid = __builtin_amdgcn_readfirstlane(tid >> 6), lane = tid & 63, wr = wid >> 2, wc = wid & 3, fr = lane & 15, fq = lane >> 4;
    const int K = g.K, nt = K / BK;
    unsigned voffA[2], voffB[2];
#pragma unroll
    for (int i = 0; i < 2; ++i) { int R, C; stage_rc(tid * 16 + i * 8192, R, C); const int Rb = Epi::PERM ? ((R & ~31) + perm32(R & 31)) : R;
        voffA[i] = (unsigned)(R * K + C) * 2u; voffB[i] = (unsigned)(Rb * K + C) * 2u; }
    const size_t kstep = (size_t)(BK * 2);
    const size_t hstep = (size_t)HALF * K * 2;
    const size_t tstep = 2 * hstep;
    const unsigned ldsw = (unsigned)wid * 1024u;
    const int aoff = lds_byte(wr * 64 + fr, fq * 8), boff = lds_byte(wc * 32 + fr, fq * 8);
#define PG8_SA(b, h) (((b) * 2 + (h)) * HTB)
#define PG8_SB(b, h) ((4 + (b) * 2 + (h)) * HTB)
#define PG8_STAGE(bufoff, gbase, voff) do { _Pragma("unroll") for (int _i = 0; _i < 2; ++_i) \
        __builtin_amdgcn_global_load_lds((const unsigned*)((const char*)(gbase) + (voff)[_i]), (PG8_LAS unsigned*)(lds + (bufoff) + ldsw + _i * 8192), 16, 0, 0); } while (0)
#define PG8_LDA(dst, b, h) do { _Pragma("unroll") for (int m = 0; m < 4; ++m) _Pragma("unroll") for (int k = 0; k < 2; ++k) dst[m][k] = *(const PG8_LAS bf16x8*)(lds + PG8_SA(b, h) + aoff + m * 2048 + k * 1024); } while (0)
#define PG8_LDB(dst, b, h) do { _Pragma("unroll") for (int n = 0; n < 2; ++n) _Pragma("unroll") for (int k = 0; k < 2; ++k) dst[n][k] = *(const PG8_LAS bf16x8*)(lds + PG8_SB(b, h) + boff + n * 2048 + k * 1024); } while (0)
#define PG8_MMA(ai, bj, At, Bt) do { __builtin_amdgcn_s_setprio(1); _Pragma("unroll") for (int m = 0; m < 4; ++m) _Pragma("unroll") for (int n = 0; n < 2; ++n) _Pragma("unroll") for (int k = 0; k < 2; ++k) \
        acc[ai][bj][m][n] = __builtin_amdgcn_mfma_f32_16x16x32_bf16(Bt[n][k], At[m][k], acc[ai][bj][m][n], 0, 0, 0); __builtin_amdgcn_s_setprio(0); } while (0)
#define PG8_WAIT_V(n) asm volatile("s_waitcnt vmcnt(" #n ")" ::: "memory")
#define PG8_WAIT_L(n) asm volatile("s_waitcnt lgkmcnt(" #n ")" ::: "memory")
#define PG8_BAR __builtin_amdgcn_s_barrier()
#define PG8_SCHED __builtin_amdgcn_sched_barrier(0)
    Unit cur, nxt; int ui = 0;
    if (!S.next(0, cur)) return;
    f32x4 acc[2][2][4][2];
#pragma unroll
    for (int a = 0; a < 2; ++a)
#pragma unroll
        for (int b = 0; b < 2; ++b)
#pragma unroll
            for (int m = 0; m < 4; ++m)
#pragma unroll
                for (int n = 0; n < 2; ++n) acc[a][b][m][n] = (f32x4){0.f, 0.f, 0.f, 0.f};
    bf16x8 At[4][2], B0[2][2], B1[2][2];
    const char* cA = (const char*)g.A + (size_t)cur.pm * tstep; const char* cB = (const char*)g.Bt + (size_t)cur.pn * tstep;
    S.a_ready(cur);
    if constexpr (SP2) {
        PG8_STAGE(PG8_SB(0, 0), cB, voffB); PG8_STAGE(PG8_SB(0, 1), cB + hstep, voffB); PG8_STAGE(PG8_SA(0, 0), cA, voffA); PG8_STAGE(PG8_SA(0, 1), cA + hstep, voffA);
        if (wr == 1) PG8_BAR;
        PG8_WAIT_V(2); PG8_BAR;
        PG8_STAGE(PG8_SB(1, 0), cB + kstep, voffB); PG8_STAGE(PG8_SA(1, 0), cA + kstep, voffA); PG8_STAGE(PG8_SB(1, 1), cB + hstep + kstep, voffB);
        PG8_WAIT_V(6); PG8_BAR;
    } else {
        PG8_STAGE(PG8_SB(0, 0), cB, voffB); PG8_STAGE(PG8_SA(0, 0), cA, voffA); PG8_STAGE(PG8_SB(0, 1), cB + hstep, voffB); PG8_STAGE(PG8_SA(0, 1), cA + hstep, voffA);
        if (wr == 1) PG8_BAR;
        PG8_WAIT_V(4); PG8_BAR;
        PG8_STAGE(PG8_SB(1, 0), cB + kstep, voffB); PG8_STAGE(PG8_SA(1, 0), cA + kstep, voffA); PG8_STAGE(PG8_SB(1, 1), cB + hstep + kstep, voffB);
        PG8_WAIT_V(6); PG8_BAR;
    }
    for (;;) {
        const bool has_next = S.next(ui + 1, nxt);
        const char* nA = has_next ? (const char*)g.A + (size_t)nxt.pm * tstep : cA; const char* nB = has_next ? (const char*)g.Bt + (size_t)nxt.pn * tstep : cB;
        for (int t = 0; t < nt; t += 2) {
            const bool last = (t == nt - 2);
            const char* a1 = cA + (size_t)(t + 1) * kstep;
            const char* a2 = last ? nA : cA + (size_t)(t + 2) * kstep; const char* b2 = last ? nB : cB + (size_t)(t + 2) * kstep;
            const char* a3 = a2 + kstep; const char* b3 = b2 + kstep;
            if (last && has_next) S.a_ready(nxt);
            if constexpr (SP2) {
            PG8_LDB(B0, 0, 0); PG8_LDB(B1, 0, 1); PG8_SCHED; PG8_LDA(At, 0, 0); PG8_STAGE(PG8_SA(1, 1), a1 + hstep, voffA);
            PG8_WAIT_V(8); PG8_WAIT_L(0); PG8_BAR; PG8_MMA(0, 0, At, B0); PG8_MMA(0, 1, At, B1); PG8_BAR; PG8_SCHED;
            PG8_LDA(At, 0, 1); PG8_STAGE(PG8_SB(0, 0), b2, voffB); PG8_STAGE(PG8_SB(0, 1), b2 + hstep, voffB); PG8_STAGE(PG8_SA(0, 0), a2, voffA);
            PG8_WAIT_V(8); PG8_WAIT_L(0); PG8_BAR; PG8_MMA(1, 0, At, B0); PG8_MMA(1, 1, At, B1); PG8_BAR; PG8_SCHED;
            PG8_LDB(B0, 1, 0); PG8_LDB(B1, 1, 1); PG8_SCHED; PG8_LDA(At, 1, 0); PG8_STAGE(PG8_SA(0, 1), a2 + hstep, voffA);
            PG8_WAIT_V(8); PG8_WAIT_L(0); PG8_BAR; PG8_MMA(0, 0, At, B0); PG8_MMA(0, 1, At, B1); PG8_BAR; PG8_SCHED;
            PG8_LDA(At, 1, 1); PG8_STAGE(PG8_SB(1, 0), b3, voffB); PG8_STAGE(PG8_SB(1, 1), b3 + hstep, voffB); PG8_STAGE(PG8_SA(1, 0), a3, voffA);
            PG8_WAIT_V(8); PG8_WAIT_L(0); PG8_BAR; PG8_MMA(1, 0, At, B0); PG8_MMA(1, 1, At, B1); PG8_BAR; PG8_SCHED;
            } else {
            PG8_LDB(B0, 0, 0); PG8_SCHED; PG8_LDA(At, 0, 0); PG8_STAGE(PG8_SA(1, 1), a1 + hstep, voffA);
            PG8_WAIT_L(8); PG8_BAR; PG8_WAIT_L(0); PG8_MMA(0, 0, At, B0); PG8_BAR; PG8_SCHED;
            PG8_LDB(B1, 0, 1); PG8_STAGE(PG8_SB(0, 0), b2, voffB);
            PG8_BAR; PG8_WAIT_L(0); PG8_MMA(0, 1, At, B1); PG8_BAR;
            PG8_LDA(At, 0, 1); PG8_STAGE(PG8_SA(0, 0), a2, voffA);
            PG8_BAR; PG8_WAIT_L(0); PG8_MMA(1, 0, At, B0); PG8_BAR; PG8_SCHED;
            PG8_STAGE(PG8_SB(0, 1), b2 + hstep, voffB);
            PG8_WAIT_V(6); PG8_BAR; PG8_MMA(1, 1, At, B1); PG8_BAR;
            PG8_LDB(B0, 1, 0); PG8_SCHED; PG8_LDA(At, 1, 0); PG8_STAGE(PG8_SA(0, 1), a2 + hstep, voffA);
            PG8_WAIT_L(8); PG8_BAR; PG8_WAIT_L(0); PG8_MMA(0, 0, At, B0); PG8_BAR; PG8_SCHED;
            PG8_LDB(B1, 1, 1); PG8_STAGE(PG8_SB(1, 0), b3, voffB);
            PG8_BAR; PG8_WAIT_L(0); PG8_MMA(0, 1, At, B1); PG8_BAR;
            PG8_LDA(At, 1, 1); PG8_STAGE(PG8_SA(1, 0), a3, voffA);
            PG8_BAR; PG8_WAIT_L(0); PG8_MMA(1, 0, At, B0); PG8_BAR; PG8_SCHED;
            PG8_STAGE(PG8_SB(1, 1), b3 + hstep, voffB);
            PG8_WAIT_V(6); PG8_BAR; PG8_MMA(1, 1, At, B1); PG8_BAR;
            }
        }
        if constexpr (ALIGN_EPI) { if (wr == 0) PG8_BAR; }
        if constexpr (!Epi::AFTER_DRAIN) { E(acc, cur, wr, wc, fr, fq); S.done(cur); }
        if (!has_next) break;
#pragma unroll
        for (int a = 0; a < 2; ++a)
#pragma unroll
            for (int b = 0; b < 2; ++b)
#pragma unroll
                for (int m = 0; m < 4; ++m)
#pragma unroll
                    for (int n = 0; n < 2; ++n) acc[a][b][m][n] = (f32x4){0.f, 0.f, 0.f, 0.f};
        cur = nxt; cA = nA; cB = nB; ++ui;
        if constexpr (ALIGN_EPI) { if (wr == 1) PG8_BAR; }
    }
    PG8_WAIT_V(0);
    if constexpr (!ALIGN_EPI) { if (wr == 0) PG8_BAR; }
    PG8_BAR;
    if constexpr (Epi::AFTER_DRAIN) { E.fused(acc, cur, wr, wc, fr, fq, lds, wid, lane); S.done(cur); }
#undef PG8_SA
#undef PG8_SB
#undef PG8_STAGE
#undef PG8_LDA
#undef PG8_LDB
#undef PG8_MMA
#undef PG8_WAIT_V
#undef PG8_WAIT_L
#undef PG8_BAR
#undef PG8_SCHED
}
}
namespace pg8 {
constexpr int RS_LDS_OFF = 131072 + 1024;
__device__ __forceinline__ float bflo(unsigned w) { return __uint_as_float(w << 16); }
__device__ __forceinline__ float bfhi(unsigned w) { return __uint_as_float(w & 0xffff0000u); }
template <bool HAS_RS> struct EpiSwiGLU {
    static constexpr bool PERM = true, AFTER_DRAIN = false;
    bf16_t* O; int ldc; PG8_LAS const float* rsl;
    __device__ __forceinline__ void operator()(const f32x4 (&acc)[2][2][4][2], const Unit& u, int wr, int wc, int fr, int fq) const {
        const int row0 = u.pm * BM + wr * 64 + fr; const int col0 = u.pn * HALF + wc * 32 + 8 * fq;
        float rsv[2][4];
#pragma unroll
        for (int ai = 0; ai < 2; ++ai)
#pragma unroll
            for (int m = 0; m < 4; ++m) rsv[ai][m] = HAS_RS ? rsl[(u.pm & 7) * 256 + wr * 64 + ai * HALF + m * 16 + fr] : 1.0f;
#pragma unroll
        for (int ai = 0; ai < 2; ++ai)
#pragma unroll
            for (int m = 0; m < 4; ++m) { bf16_t* rowp = O + (size_t)(row0 + ai * HALF + m * 16) * ldc + col0; const float rs = rsv[ai][m];
                float hv[8];
#pragma unroll
                for (int n = 0; n < 2; ++n)
#pragma unroll
                    for (int e = 0; e < 4; ++e) { const float g = acc[ai][0][m][n][e] * rs, up = acc[ai][1][m][n][e] * rs;
                        const float ex = __builtin_amdgcn_exp2f(-g * 1.4426950408889634f);
                        hv[n * 4 + e] = g * __builtin_amdgcn_rcpf(1.0f + ex) * up; }
                u32x4 w; w.x = cvt_pk_bf16(hv[0], hv[1]); w.y = cvt_pk_bf16(hv[2], hv[3]); w.z = cvt_pk_bf16(hv[4], hv[5]); w.w = cvt_pk_bf16(hv[6], hv[7]);
                *(u32x4*)rowp = w; }
    }
};
struct EpiBf16Rs {
    static constexpr bool PERM = true, AFTER_DRAIN = false;
    bf16_t* O; int ldc; PG8_LAS const float* rsl;
    __device__ __forceinline__ void operator()(const f32x4 (&acc)[2][2][4][2], const Unit& u, int wr, int wc, int fr, int fq) const {
        const int row0 = u.pm * BM + wr * 64 + fr; const int col0 = u.pn * BM + wc * 32 + 8 * fq;
        float rsv[2][4];
#pragma unroll
        for (int ai = 0; ai < 2; ++ai)
#pragma unroll
            for (int m = 0; m < 4; ++m) rsv[ai][m] = rsl[(u.pm & 7) * 256 + wr * 64 + ai * HALF + m * 16 + fr];
#pragma unroll
        for (int ai = 0; ai < 2; ++ai)
#pragma unroll
            for (int m = 0; m < 4; ++m) { bf16_t* rowp = O + (size_t)(row0 + ai * HALF + m * 16) * ldc + col0; const float rs = rsv[ai][m];
#pragma unroll
                for (int bj = 0; bj < 2; ++bj) { const f32x4 v0 = acc[ai][bj][m][0] * rs, v1 = acc[ai][bj][m][1] * rs;
                    u32x4 w; w.x = cvt_pk_bf16(v0[0], v0[1]); w.y = cvt_pk_bf16(v0[2], v0[3]); w.z = cvt_pk_bf16(v1[0], v1[1]); w.w = cvt_pk_bf16(v1[2], v1[3]);
                    *(u32x4*)(rowp + bj * HALF) = w; } }
    }
};
template <bool BASE_BF16, int ALPHA_X2, size_t SS_OFF> struct EpiResidB {
    static constexpr bool PERM = true, AFTER_DRAIN = false;
    const void* base; bf16_t* out; int ldc; unsigned char* wsb;
    __device__ __forceinline__ void operator()(const f32x4 (&acc)[2][2][4][2], const Unit& u, int wr, int wc, int fr, int fq) const {
        const int row0 = u.pm * BM + wr * 64 + fr; const int col0 = u.pn * BM + wc * 32 + 8 * fq; const int lane = fr + 16 * fq; constexpr float alpha = 0.5f * ALPHA_X2;
        float* ssp = (float*)(wsb + SS_OFF);
#pragma unroll
        for (int ai = 0; ai < 2; ++ai) {
            u32x4 bb[4][2]; f32x4 bf[4][2][2];
#pragma unroll
            for (int m = 0; m < 4; ++m) { const size_t ro = (size_t)(row0 + ai * HALF + m * 16) * ldc + col0;
#pragma unroll
                for (int bj = 0; bj < 2; ++bj) {
                    if (BASE_BF16) bb[m][bj] = *(const u32x4*)((const bf16_t*)base + ro + bj * HALF);
                    else { bf[m][bj][0] = *(const f32x4*)((const float*)base + ro + bj * HALF); bf[m][bj][1] = *(const f32x4*)((const float*)base + ro + bj * HALF + 4); } } }
            asm volatile("" ::: "memory");
#pragma unroll
            for (int m = 0; m < 4; ++m) { const int row = row0 + ai * HALF + m * 16; const size_t ro = (size_t)row * ldc + col0; float sq = 0.f;
#pragma unroll
                for (int bj = 0; bj < 2; ++bj) { f32x4 b0, b1;
                    if (BASE_BF16) { const u32x4 w = bb[m][bj]; b0 = (f32x4){bflo(w.x), bfhi(w.x), bflo(w.y), bfhi(w.y)}; b1 = (f32x4){bflo(w.z), bfhi(w.z), bflo(w.w), bfhi(w.w)}; }
                    else { b0 = bf[m][bj][0]; b1 = bf[m][bj][1]; }
                    const f32x4 v0 = b0 + acc[ai][bj][m][0] * alpha, v1 = b1 + acc[ai][bj][m][1] * alpha;
                    sq += ((v0[0] * v0[0] + v0[1] * v0[1]) + (v0[2] * v0[2] + v0[3] * v0[3])) + ((v1[0] * v1[0] + v1[1] * v1[1]) + (v1[2] * v1[2] + v1[3] * v1[3]));
                    u32x4 o; o.x = cvt_pk_bf16(v0[0], v0[1]); o.y = cvt_pk_bf16(v0[2], v0[3]); o.z = cvt_pk_bf16(v1[0], v1[1]); o.w = cvt_pk_bf16(v1[2], v1[3]);
                    *(u32x4*)(out + ro + bj * HALF) = o; }
                sq += __int_as_float(__builtin_amdgcn_ds_bpermute((lane ^ 16) << 2, __float_as_int(sq))); sq += __int_as_float(__builtin_amdgcn_ds_bpermute((lane ^ 32) << 2, __float_as_int(sq)));
                if (fq == 0) ssp[(size_t)row * 32 + u.pn * 4 + wc] = sq; }
            asm volatile("" ::: "memory");
        }
    }
};
}

namespace cg = cooperative_groups;
#define LAS __attribute__((address_space(3)))
#define DI __device__ __forceinline__
typedef unsigned short bf16_t;
typedef short bf16x8 __attribute__((ext_vector_type(8)));
typedef short s16x4 __attribute__((ext_vector_type(4)));
typedef float f32x4 __attribute__((ext_vector_type(4)));
typedef float f32x2 __attribute__((ext_vector_type(2)));
typedef float f32x16 __attribute__((ext_vector_type(16)));
typedef unsigned u32x4 __attribute__((ext_vector_type(4)));
typedef unsigned u32x2 __attribute__((ext_vector_type(2)));
typedef __bf16 bf16x2_t __attribute__((ext_vector_type(2)));

constexpr int BATCH = 8, SEQ = 2048, DM = 2048, DFF = 5632, INC = 6144, M = BATCH * SEQ;
constexpr float EPS = 1e-5f;
constexpr float LOG2E = 1.4426950408889634f;
constexpr float QSCALE = 0.08838834764831845f * LOG2E;
constexpr int NWAVES = 8, NTHREADS = 512;

constexpr size_t MiB = 1u << 20;
constexpr size_t WS_CTL = 0;
constexpr size_t WS_WGU1 = 1 * MiB, WS_WD1 = 45 * MiB, WS_WIN = 67 * MiB, WS_WOUT = 91 * MiB, WS_WGU2 = 99 * MiB, WS_WD2 = 143 * MiB;
constexpr size_t WS_XN = 166 * MiB;
constexpr size_t WS_BIG = 230 * MiB;
constexpr size_t WS_SSP = 422 * MiB;
constexpr size_t WS_END = 428 * MiB;
constexpr int RING_BYTES = 131072, MISC_OFF = RING_BYTES, LDS_BYTES = RING_BYTES + 1024 + 8192;

DI unsigned cvtpk(float lo, float hi) { f32x2 v = {lo, hi}; bf16x2_t b = __builtin_convertvector(v, bf16x2_t); return __builtin_bit_cast(unsigned, b); }
DI float bf2f(unsigned short s) { return __uint_as_float((unsigned)s << 16); }
DI float shx(float v, int o, int lane) { return __int_as_float(__builtin_amdgcn_ds_bpermute((lane ^ o) << 2, __float_as_int(v))); }
DI float swap32(float v, int h) { auto rr = __builtin_amdgcn_permlane32_swap(__float_as_uint(v), __float_as_uint(v), false, false); return __uint_as_float(h ? rr[0] : rr[1]); }
DI float wave_sum(float v, int lane) {
#pragma unroll
    for (int o = 1; o < 64; o <<= 1) v += shx(v, o, lane);
    return v;
}
DI void block_sync() { asm volatile("s_waitcnt vmcnt(0) lgkmcnt(0)" ::: "memory"); __builtin_amdgcn_s_barrier(); asm volatile("" ::: "memory"); }

template <bool HAS_GAIN> DI void transpose_item(const float* __restrict__ W, int K, int N, bf16_t* __restrict__ WT, int mode, int slo, int shi, float scale, const float* __restrict__ kgain, LAS float* scr, int item, int lane) {
    asm volatile("" : "+v"(lane));
    const int nblk = N / 32, kb = item / nblk, nb = item % nblk, k0 = 64 * kb, n0 = 32 * nb;
    float gvec = 1.0f; if (HAS_GAIN) gvec = kgain[k0 + lane];
#pragma unroll 8
    for (int i = 0; i < 32; ++i) { const int kk = 2 * i + (lane >> 5); float wv = W[(size_t)(k0 + kk) * N + n0 + (lane & 31)];
        if (HAS_GAIN) { const float g0 = __uint_as_float(__builtin_amdgcn_readlane(__float_as_uint(gvec), 2 * i)), g1 = __uint_as_float(__builtin_amdgcn_readlane(__float_as_uint(gvec), 2 * i + 1)); wv *= (lane >> 5) ? g1 : g0; }
        scr[kk * 33 + (lane & 31)] = wv; }
    asm volatile("s_waitcnt lgkmcnt(0)" ::: "memory");
    const int c = lane & 7;
    const float sc = (n0 >= slo && n0 < shi) ? scale : 1.0f;
    const int rbase = mode == 0 ? n0 : ((n0 >> 7) * 256 + (n0 & 127) + (mode == 2 ? 128 : 0));
#pragma unroll
    for (int j = 0; j < 4; ++j) { const int n = (lane >> 3) + 8 * j; const LAS float* s = scr + (8 * c) * 33 + n;
        u32x4 o; o.x = cvtpk(s[0 * 33] * sc, s[1 * 33] * sc); o.y = cvtpk(s[2 * 33] * sc, s[3 * 33] * sc); o.z = cvtpk(s[4 * 33] * sc, s[5 * 33] * sc); o.w = cvtpk(s[6 * 33] * sc, s[7 * 33] * sc);
        *(u32x4*)(WT + (size_t)(rbase + n) * K + k0 + 8 * c) = o; }
    asm volatile("s_waitcnt lgkmcnt(0)" ::: "memory");
}

template <bool F32OUT> DI void rms_rows(const float* src, const float* __restrict__ gain, bf16_t* dstb, float* dstf, int gw, int NGW, int lane) {
    asm volatile("" : "+v"(lane));
    for (int m = gw; m < M; m += NGW) {
        const f32x4* xr = (const f32x4*)(src + (size_t)m * DM) + lane;
        f32x4 v[8]; float s = 0.f;
#pragma unroll
        for (int j = 0; j < 8; ++j) { v[j] = xr[64 * j]; s += (v[j].x * v[j].x + v[j].y * v[j].y) + (v[j].z * v[j].z + v[j].w * v[j].w); }
        const float rstd = 1.0f / sqrtf(wave_sum(s, lane) * (1.0f / DM) + EPS);
#pragma unroll
        for (int j = 0; j < 8; ++j) { const f32x4 g = ((const f32x4*)gain)[lane + 64 * j]; const f32x4 y = v[j] * rstd * g;
            if (F32OUT) ((f32x4*)(dstf + (size_t)m * DM))[lane + 64 * j] = y;
            else { u32x2 w; w.x = cvtpk(y.x, y.y); w.y = cvtpk(y.z, y.w); ((u32x2*)(dstb + (size_t)m * DM))[lane + 64 * j] = w; } }
    }
}

DI void build_rs(LAS float* rsl, const float* __restrict__ ssp, int fm, int wid, int lane) {
    asm volatile("" : "+v"(lane));
#pragma unroll 2
    for (int k = 0; k < 8; ++k) { const int rl = wid * 32 + (lane >> 1); const f32x4* p = (const f32x4*)(ssp + ((size_t)(fm + k) * 256 + rl) * 32 + (lane & 1) * 16);
        const f32x4 a = p[0], b = p[1], c = p[2], d = p[3]; float sm = ((a.x + a.y) + (a.z + a.w)) + ((b.x + b.y) + (b.z + b.w)) + ((c.x + c.y) + (c.z + c.w)) + ((d.x + d.y) + (d.z + d.w));
        sm += shx(sm, 1, lane);
        if ((lane & 1) == 0) rsl[k * 256 + rl] = 1.0f / sqrtf(sm * (1.0f / DM) + EPS); }
    block_sync();
}
DI void final_rows(float* __restrict__ out, const bf16_t* __restrict__ xb, const float* __restrict__ ssp, const float* __restrict__ gain, int gw, int NGW, int lane) {
    asm volatile("" : "+v"(lane));
    for (int m = gw; m < M; m += NGW) {
        const u32x4* xr = (const u32x4*)(xb + (size_t)m * DM) + lane;
        u32x4 raw[4];
#pragma unroll
        for (int j = 0; j < 4; ++j) raw[j] = xr[64 * j];
        const float rstd = 1.0f / sqrtf(wave_sum(lane < 32 ? ssp[(size_t)m * 32 + lane] : 0.f, lane) * (1.0f / DM) + EPS);
        f32x4* orow = (f32x4*)(out + (size_t)m * DM);
#pragma unroll
        for (int j = 0; j < 4; ++j) { const int c8 = lane + 64 * j; const f32x4 g0 = ((const f32x4*)gain)[2 * c8], g1 = ((const f32x4*)gain)[2 * c8 + 1]; const u32x4 w = raw[j];
            f32x4 y0 = {__uint_as_float(w.x << 16), __uint_as_float(w.x & 0xffff0000u), __uint_as_float(w.y << 16), __uint_as_float(w.y & 0xffff0000u)};
            f32x4 y1 = {__uint_as_float(w.z << 16), __uint_as_float(w.z & 0xffff0000u), __uint_as_float(w.w << 16), __uint_as_float(w.w & 0xffff0000u)};
            orow[2 * c8] = y0 * rstd * g0; orow[2 * c8 + 1] = y1 * rstd * g1; }
    }
}

DI void qknorm_rows(bf16_t* U, const float* __restrict__ qn, const float* __restrict__ kn, int gw, int NGW, int lane) {
    asm volatile("" : "+v"(lane));
    const int cw = lane & 15;
    for (int m = gw; m < M; m += NGW) {
        const int pos = m & (SEQ - 1);
        float cs[8], sn[8];
        if (cw < 4) {
#pragma unroll
            for (int e = 0; e < 8; ++e) { const int fi = 8 * (cw & 1) + e;
                const float invf = exp2f(-(float)fi * (18.931568569324174f / 16.0f));
                const float ang = (float)pos * invf;
                double rv = (double)ang * 0.15915494309189535; rv -= __builtin_rint(rv); const float fr = (float)rv;
                cs[e] = __builtin_amdgcn_cosf(fr); sn[e] = __builtin_amdgcn_sinf(fr); }
        } else {
#pragma unroll
            for (int e = 0; e < 8; ++e) { cs[e] = 1.f; sn[e] = 0.f; }
        }
        bf16_t* urow = U + (size_t)m * INC;
        u32x4 raws[4];
#pragma unroll
        for (int j = 0; j < 4; ++j) raws[j] = ((const u32x4*)urow)[lane + 64 * j];
#pragma unroll
        for (int j = 0; j < 4; ++j) {
            const u32x4 raw = raws[j];
            float v[8];
#pragma unroll
            for (int e = 0; e < 4; ++e) { v[2 * e] = __uint_as_float(raw[e] << 16); v[2 * e + 1] = __uint_as_float(raw[e] & 0xffff0000u); }
            float ss = 0.f;
#pragma unroll
            for (int e = 0; e < 8; ++e) ss += v[e] * v[e];
            ss += shx(ss, 1, lane); ss += shx(ss, 2, lane); ss += shx(ss, 4, lane); ss += shx(ss, 8, lane);
            const float rstd = 1.0f / sqrtf(ss * (1.0f / 128.0f) + EPS);
            const float* gp = (j < 2 ? qn : kn) + 8 * cw;
            const f32x4 g0 = *(const f32x4*)gp, g1 = *(const f32x4*)(gp + 4);
            float y[8];
#pragma unroll
            for (int e = 0; e < 8; ++e) y[e] = v[e] * rstd * (e < 4 ? g0[e] : g1[e - 4]);
            const float sgn = (cw < 2) ? -1.f : 1.f;
#pragma unroll
            for (int e = 0; e < 8; ++e) { const float yp = shx(y[e], 2, lane); y[e] = y[e] * cs[e] + sgn * yp * sn[e]; }
            if (j < 2) {
#pragma unroll
                for (int e = 0; e < 8; ++e) y[e] *= QSCALE;
            }
            u32x4 w; w.x = cvtpk(y[0], y[1]); w.y = cvtpk(y[2], y[3]); w.z = cvtpk(y[4], y[5]); w.w = cvtpk(y[6], y[7]);
            ((u32x4*)urow)[lane + 64 * j] = w;
        }
    }
}

namespace att {
constexpr int ULD = INC, STAGE = 65536;
constexpr float NEG = -1e30f;
DI int crow(int i, int h) { return (i & 3) + 8 * (i >> 2) + 4 * h; }
DI void glds16(const void* g, LAS unsigned char* l) { __builtin_amdgcn_global_load_lds((const unsigned*)g, (LAS unsigned*)l, 16, 0, 0); }
template <int MODE> DI void load_tile128(const bf16_t* g, LAS unsigned char* dst, int wid, int lane) {
#pragma unroll
    for (int t = 0; t < 2; ++t) { const int ci = wid + 8 * t, R = 4 * ci + (lane >> 4), cp = lane & 15;
        const int c = MODE == 0 ? (cp ^ (R & 15)) : ((((cp >> 2) ^ (R & 3)) << 2) | (cp & 3));
        glds16(g + (size_t)R * ULD + c * 8, dst + ci * 1024); }
}
DI void load_tile256(const bf16_t* g, LAS unsigned char* dst, int wid, int lane) {
#pragma unroll
    for (int t = 0; t < 4; ++t) { const int ci = wid + 8 * t, R = 2 * ci + (lane >> 5), cp = lane & 31;
        const int c = (((cp >> 2) ^ (R & 3)) << 2) | (cp & 3);
        glds16(g + (size_t)R * ULD + c * 8, dst + ci * 1024); }
}
DI s16x4 vtr(const LAS unsigned char* p) { typedef short v4i16_t __attribute__((ext_vector_type(4))); return __builtin_bit_cast(s16x4, __builtin_amdgcn_ds_read_tr16_b64_v4i16((LAS v4i16_t*)p)); }
DI bf16x8 pack8(const f32x16& x, int s) {
    u32x4 p; p.x = cvtpk(x[8 * s], x[8 * s + 1]); p.y = cvtpk(x[8 * s + 2], x[8 * s + 3]); p.z = cvtpk(x[8 * s + 4], x[8 * s + 5]); p.w = cvtpk(x[8 * s + 6], x[8 * s + 7]);
    return __builtin_bit_cast(bf16x8, p);
}
#define MFMA32(a, b, c) __builtin_amdgcn_mfma_f32_32x32x16_bf16((a), (b), (c), 0, 0, 0)
DI void qk_tile(f32x16 (&sT)[2], const LAS unsigned char* kimg, const bf16x8 (&qf)[8], int r, int h) {
    const LAS unsigned char* kp = kimg + r * 256; const int sw = r & 15;
    bf16x8 kf[2][2][2];
#define QK_LOAD(bt) do { _Pragma("unroll") for (int s2 = 0; s2 < 2; ++s2) _Pragma("unroll") for (int kb = 0; kb < 2; ++kb) \
        kf[(bt) & 1][s2][kb] = *(const LAS bf16x8*)(kp + kb * 8192 + (((2 * (2 * (bt) + s2) + h) ^ sw) << 4)); } while (0)
    QK_LOAD(0);
    f32x16 a0 = {}, a1 = {};
#pragma unroll
    for (int bt = 0; bt < 4; ++bt) {
        if (bt + 1 < 4) QK_LOAD(bt + 1);
        __builtin_amdgcn_sched_barrier(0);
#pragma unroll
        for (int s2 = 0; s2 < 2; ++s2) { a0 = MFMA32(kf[bt & 1][s2][0], qf[2 * bt + s2], a0); a1 = MFMA32(kf[bt & 1][s2][1], qf[2 * bt + s2], a1); }
        __builtin_amdgcn_sched_barrier(0);
    }
#undef QK_LOAD
    sT[0] = a0; sT[1] = a1;
}
DI f32x16 qk_half_lq(const LAS unsigned char* kimg32, const LAS unsigned char* qimg, int r, int h) {
    const int sw = r & 15; const LAS unsigned char* kp = kimg32 + r * 256; const LAS unsigned char* qp = qimg + r * 256;
    bf16x8 kf[2][2], qv[2][2];
#define QK_LOAD(bt) do { _Pragma("unroll") for (int s2 = 0; s2 < 2; ++s2) { const int co = (((2 * (2 * (bt) + s2) + h) ^ sw) << 4); qv[(bt) & 1][s2] = *(const LAS bf16x8*)(qp + co); \
        kf[(bt) & 1][s2] = *(const LAS bf16x8*)(kp + co); } } while (0)
    QK_LOAD(0);
    f32x16 a0 = {};
#pragma unroll
    for (int bt = 0; bt < 4; ++bt) {
        if (bt + 1 < 4) QK_LOAD(bt + 1);
        __builtin_amdgcn_sched_barrier(0);
#pragma unroll
        for (int s2 = 0; s2 < 2; ++s2) a0 = MFMA32(kf[bt & 1][s2], qv[bt & 1][s2], a0);
        __builtin_amdgcn_sched_barrier(0);
    }
#undef QK_LOAD
    return a0;
}
template <int RB> DI void pv_half(f32x16 (&o)[4], const f32x16& x, const LAS unsigned char* vimg, int lane, int kb) {
    const int h = lane >> 5, half = (lane >> 4) & 1, q = (lane & 15) >> 2, p = lane & 3;
    const LAS unsigned char* vb = vimg + (32 * kb + 4 * h + q) * RB + 32 * half + 8 * p;
    s16x4 lo[2][4], hi[2][4];
#pragma unroll
    for (int db = 0; db < 4; ++db) { const LAS unsigned char* a = vb + ((db ^ q) << 6); lo[0][db] = vtr(a); hi[0][db] = vtr(a + 8 * RB); }
#pragma unroll
    for (int s = 0; s < 2; ++s) {
        const bf16x8 pf = pack8(x, s);
        if (s == 0) {
#pragma unroll
            for (int db = 0; db < 4; ++db) { const LAS unsigned char* a = vb + ((db ^ q) << 6) + 16 * RB; lo[1][db] = vtr(a); hi[1][db] = vtr(a + 8 * RB); }
        }
        __builtin_amdgcn_sched_barrier(0);
#pragma unroll
        for (int db = 0; db < 4; ++db) { const bf16x8 vf = __builtin_shufflevector(lo[s][db], hi[s][db], 0, 1, 2, 3, 4, 5, 6, 7); o[db] = MFMA32(vf, pf, o[db]); }
        __builtin_amdgcn_sched_barrier(0);
    }
}
template <int RB> DI void pv_tile(f32x16 (&o)[4], const f32x16 (&sT)[2], const LAS unsigned char* vimg, int lane, int db0) {
    const int h = lane >> 5, half = (lane >> 4) & 1, q = (lane & 15) >> 2, p = lane & 3;
    const LAS unsigned char* vb = vimg + (4 * h + q) * RB + 32 * half + 8 * p;
    const LAS unsigned char* va[4];
#pragma unroll
    for (int db = 0; db < 4; ++db) va[db] = vb + (((db0 + db) ^ q) << 6);
    s16x4 lo[2][4], hi[2][4];
#pragma unroll
    for (int db = 0; db < 4; ++db) { lo[0][db] = vtr(va[db]); hi[0][db] = vtr(va[db] + 8 * RB); }
#pragma unroll
    for (int s = 0; s < 4; ++s) {
        const bf16x8 pf = pack8(sT[s >> 1], s & 1);
        if (s + 1 < 4) {
#pragma unroll
            for (int db = 0; db < 4; ++db) { lo[(s + 1) & 1][db] = vtr(va[db] + 16 * (s + 1) * RB); hi[(s + 1) & 1][db] = vtr(va[db] + 16 * (s + 1) * RB + 8 * RB); }
        }
        __builtin_amdgcn_sched_barrier(0);
#pragma unroll
        for (int db = 0; db < 4; ++db) { const bf16x8 vf = __builtin_shufflevector(lo[s & 1][db], hi[s & 1][db], 0, 1, 2, 3, 4, 5, 6, 7); o[db] = MFMA32(vf, pf, o[db]); }
        __builtin_amdgcn_sched_barrier(0);
    }
}

DI f32x16 qk_half(const LAS unsigned char* kimg32, const bf16x8 (&qf)[8], int r, int h) {
    const int sw = r & 15; const LAS unsigned char* kp = kimg32 + r * 256;
    bf16x8 kf[8];
#pragma unroll
    for (int s = 0; s < 8; ++s) kf[s] = *(const LAS bf16x8*)(kp + (((2 * s + h) ^ sw) << 4));
    f32x16 a0 = {};
#pragma unroll
    for (int s = 0; s < 8; ++s) a0 = MFMA32(kf[s], qf[s], a0);
    return a0;
}
DI void diff_unit(int bh, int qb, const bf16_t* __restrict__ U, bf16_t* __restrict__ AO, const float* __restrict__ subln, float lam, LAS unsigned char* lds, int wid, int lane) {
    asm volatile("" : "+v"(lane));
    const int b = bh >> 2, hd = bh & 3, r = lane & 31, h = lane >> 5, pi = wid >> 2, map = (wid >> 1) & 1, dh = wid & 1;
    const int q0w = qb * 64 + 32 * pi;
    const size_t rowbase = (size_t)b * SEQ;
    bf16x8 qf[8];
    { const bf16_t* Qp = U + (rowbase + q0w + r) * ULD + map * 512 + hd * 128 + h * 8;
#pragma unroll
      for (int s = 0; s < 8; ++s) qf[s] = *(const bf16x8*)(Qp + 16 * s); }
    const int NB = 2 * qb + 2, mynb = 2 * qb + pi + 1;
    const bf16_t* Kg1 = U + rowbase * ULD + 1024 + hd * 128;
    const bf16_t* Vg = U + rowbase * ULD + 2048 + hd * 256;
    unsigned offK, offV0, offV1;
    { const int R = 4 * wid + (lane >> 4), cp = lane & 15; offK = (unsigned)(R * ULD + ((cp ^ (R & 15)) << 3)); }
    { const int cp = lane & 31; const int R0 = 2 * wid + (lane >> 5), R1 = R0 + 16;
      offV0 = (unsigned)(R0 * ULD + (((((cp >> 2) ^ (R0 & 3)) << 2) | (cp & 3)) << 3)); offV1 = (unsigned)(R1 * ULD + (((((cp >> 2) ^ (R1 & 3)) << 2) | (cp & 3)) << 3)); }
#define DIFF_PIECE(j, p) do { const int jj_ = (j) < 63 ? (j) : 63; const size_t ko = (size_t)(32 * jj_) * ULD; LAS unsigned char* sp_ = lds + ((j) & 3) * 32768 + wid * 1024; \
        if ((p) == 0) glds16(Kg1 + ko + offK, sp_); else if ((p) == 1) glds16(Kg1 + 512 + ko + offK, sp_ + 8192); else if ((p) == 2) glds16(Vg + ko + offV0, sp_ + 16384); else glds16(Vg + ko + offV1, sp_ + 24576); } while (0)
#define DIFF_ISSUE(j) do { DIFF_PIECE(j, 0); DIFF_PIECE(j, 1); DIFF_PIECE(j, 2); DIFF_PIECE(j, 3); } while (0)
#define DIFF_SYNC() asm volatile("s_waitcnt vmcnt(4) lgkmcnt(0)\n\ts_barrier" ::: "memory")
    f32x16 o[4];
#pragma unroll
    for (int d = 0; d < 4; ++d) o[d] = (f32x16){};
    float mrun = NEG, lrun = 0.f;
    DIFF_ISSUE(0); DIFF_ISSUE(1); DIFF_ISSUE(2);
    asm volatile("s_waitcnt vmcnt(0) lgkmcnt(0)\n\ts_barrier" ::: "memory");
    f32x16 scur = qk_half(lds + map * 8192, qf, r, h);
    const int hq = lane >> 5, half = (lane >> 4) & 1, vq = (lane & 15) >> 2, vp = lane & 3;
    const int voff = 16384 + (4 * hq + vq) * 512 + 32 * half + 8 * vp;
    const int ksw = r & 15;
#define DIFF_MAX() do { float mx = scur[0]; _Pragma("unroll") for (int i = 1; i < 16; ++i) mx = fmaxf(mx, scur[i]); mx = fmaxf(mx, swap32(mx, h)); const float mnew = fmaxf(mrun, mx); \
        if (__any(mnew > mrun)) { const float f = __builtin_amdgcn_exp2f(mrun - mnew); lrun *= f; _Pragma("unroll") for (int d = 0; d < 4; ++d) o[d] = o[d] * f; mrun = mnew; } } while (0)
#define DIFF_VREAD(j) do { const LAS unsigned char* vb = lds + ((j) & 3) * 32768 + voff; _Pragma("unroll") for (int s_ = 0; s_ < 2; ++s_) _Pragma("unroll") for (int db = 0; db < 4; ++db) { \
        const LAS unsigned char* a_ = vb + 16 * s_ * 512 + (((4 * dh + db) ^ vq) << 6); lo[s_][db] = vtr(a_); hi[s_][db] = vtr(a_ + 8 * 512); } } while (0)
#define DIFF_PV() do { _Pragma("unroll") for (int s_ = 0; s_ < 2; ++s_) { const bf16x8 pf = pack8(scur, s_); _Pragma("unroll") for (int db = 0; db < 4; ++db) { \
        const bf16x8 vf = __builtin_shufflevector(lo[s_][db], hi[s_][db], 0, 1, 2, 3, 4, 5, 6, 7); o[db] = MFMA32(vf, pf, o[db]); } } } while (0)
    int j = 0;
    for (; j < mynb - 1; ++j) {
        DIFF_MAX();
        DIFF_SYNC();
        bf16x8 kf[8]; s16x4 lo[2][4], hi[2][4];
        { const LAS unsigned char* kp = lds + ((j + 1) & 3) * 32768 + map * 8192 + r * 256;
#pragma unroll
          for (int s = 0; s < 8; ++s) kf[s] = *(const LAS bf16x8*)(kp + (((2 * s + h) ^ ksw) << 4)); }
        __builtin_amdgcn_sched_barrier(0);
        f32x16 sn = {}; float ps = 0.f;
        const LAS unsigned char* vbj = lds + (j & 3) * 32768 + voff;
#pragma unroll
        for (int s = 0; s < 8; ++s) {
            sn = MFMA32(kf[s], qf[s], sn);
            if (s < 4) {
#pragma unroll
                for (int s_ = 0; s_ < 2; ++s_) { const LAS unsigned char* a_ = vbj + 16 * s_ * 512 + (((4 * dh + s) ^ vq) << 6); lo[s_][s] = vtr(a_); hi[s_][s] = vtr(a_ + 8 * 512); }
            }
            if ((s & 1) == 0) DIFF_PIECE(j + 3, s >> 1);
            const float e0 = __builtin_amdgcn_exp2f(scur[2 * s] - mrun), e1 = __builtin_amdgcn_exp2f(scur[2 * s + 1] - mrun);
            scur[2 * s] = e0; scur[2 * s + 1] = e1; ps += e0 + e1;
            __builtin_amdgcn_sched_barrier(0);
        }
        lrun += ps;
        DIFF_PV();
        scur = sn;
    }
    {
#pragma unroll
        for (int i = 0; i < 16; ++i) if (crow(i, h) > r) scur[i] = NEG;
        DIFF_MAX();
        DIFF_SYNC();
        DIFF_ISSUE(j + 3);
        s16x4 lo[2][4], hi[2][4];
        DIFF_VREAD(j);
        float ps = 0.f;
#pragma unroll
        for (int i = 0; i < 16; ++i) { const float pe = __builtin_amdgcn_exp2f(scur[i] - mrun); scur[i] = pe; ps += pe; }
        lrun += ps;
        DIFF_PV();
        ++j;
    }
    for (; j < NB; ++j) { DIFF_SYNC(); DIFF_ISSUE(j + 3); }
#undef DIFF_MAX
#undef DIFF_VREAD
#undef DIFF_PV
#undef DIFF_SYNC
#undef DIFF_PIECE
#undef DIFF_ISSUE
    block_sync();
    const float ltot = lrun + swap32(lrun, h);
    LAS float* comb = (LAS float*)(lds + (pi * 2 + dh) * 16384) + lane;
    LAS float* ssb = (LAS float*)(lds + 65536);
    if (map == 1) {
        const float sc = lam / ltot;
#pragma unroll
        for (int d = 0; d < 4; ++d)
#pragma unroll
            for (int i = 0; i < 16; ++i) comb[(d * 16 + i) * 64] = o[d][i] * sc;
    }
    block_sync();
    if (map == 0) {
        const float sc = 1.0f / ltot; float ss = 0.f;
#pragma unroll
        for (int d = 0; d < 4; ++d)
#pragma unroll
            for (int i = 0; i < 16; ++i) { const float v = o[d][i] * sc - comb[(d * 16 + i) * 64]; o[d][i] = v; ss += v * v; }
        ss += swap32(ss, h);
        if (h == 0) ssb[(pi * 2 + dh) * 32 + r] = ss;
    }
    block_sync();
    if (map == 0) {
        const float ss = ssb[(pi * 2) * 32 + r] + ssb[(pi * 2 + 1) * 32 + r];
        const float rstd = 0.8f / sqrtf(ss * (1.0f / 256.0f) + EPS);
        bf16_t* orow = AO + (rowbase + q0w + r) * DM + hd * 256 + dh * 128 + 4 * h;
        const float* gp = subln + dh * 128 + 4 * h;
#pragma unroll
        for (int d = 0; d < 4; ++d)
#pragma unroll
            for (int g = 0; g < 4; ++g) { const f32x4 gv = *(const f32x4*)(gp + 32 * d + 8 * g);
                u32x2 w; w.x = cvtpk(o[d][4 * g] * rstd * gv.x, o[d][4 * g + 1] * rstd * gv.y); w.y = cvtpk(o[d][4 * g + 2] * rstd * gv.z, o[d][4 * g + 3] * rstd * gv.w);
                *(u32x2*)(orow + 32 * d + 8 * g) = w; }
    }
    block_sync();
}

template <bool MASKED> DI void sb_weights(f32x16& x, float& base, int kbase  , int qg, int h) {
    float L[16];
#pragma unroll
    for (int i = 0; i < 16; ++i) { const float z = x[i]; const float e = __builtin_amdgcn_exp2f(-fabsf(z));
        float l2 = -(fmaxf(z, 0.f) + __builtin_amdgcn_logf(1.0f + e));
        if (MASKED) { const int kg = kbase + crow(i, h); if (!(kg < qg)) l2 = 0.f; }
        L[i] = l2; if ((i & 7) == 7) __builtin_amdgcn_sched_barrier(0); }
    float T[4], To[4];
#pragma unroll
    for (int g = 0; g < 4; ++g) { L[4 * g + 2] += L[4 * g + 3]; L[4 * g + 1] += L[4 * g + 2]; L[4 * g] += L[4 * g + 1]; T[g] = L[4 * g]; To[g] = swap32(T[g], h); }
    float off[4]; float suf = 0.f;
#pragma unroll
    for (int g = 3; g >= 0; --g) { off[g] = suf + (h == 0 ? To[g] : 0.f); suf += T[g] + To[g]; }
#pragma unroll
    for (int i = 0; i < 16; ++i) { const float c = L[i] + off[i >> 2] + base; float a = __builtin_amdgcn_exp2f(x[i] + c);
        if (MASKED) { const int kg = kbase + crow(i, h); if (!(kg < qg)) a = 0.f; }
        x[i] = a; if ((i & 7) == 7) __builtin_amdgcn_sched_barrier(0); }
    base += suf;
}
constexpr float SB_CUT = 48.0f;
DI void sb_unit(int bh, int qb, const bf16_t* __restrict__ U, bf16_t* __restrict__ AO, LAS unsigned char* lds, int wid, int lane) {
    asm volatile("" : "+v"(lane));
    const int b = bh >> 3, hd = bh & 7, r = lane & 31, h = lane >> 5;
    const int q0w = qb * 256 + 32 * wid;
    const size_t rowbase = (size_t)b * SEQ;
    LAS unsigned char* qimg = lds + (wid < 4 ? 32768 + wid * 8192 : 98304 + (wid - 4) * 8192);
    { const bf16_t* Qp = U + (rowbase + q0w) * ULD + 3072 + hd * 128;
#pragma unroll
      for (int t = 0; t < 8; ++t) { const int Rr = 4 * t + (lane >> 4), cp = lane & 15; glds16(Qp + (size_t)Rr * ULD + ((cp ^ (Rr & 15)) << 3), qimg + t * 1024); } }
    const bf16_t* Kg = U + rowbase * ULD + 4096 + hd * 128;
    const bf16_t* Vg = U + rowbase * ULD + 5120 + hd * 128;
    const int NT = 4 * qb + 4;
    volatile LAS int* flags = (volatile LAS int*)(lds + MISC_OFF + 64);
    f32x16 o[4];
#pragma unroll
    for (int d = 0; d < 4; ++d) o[d] = (f32x16){};
    float R = 0.f;
#define SB_ISSUE(kt, st) do { const size_t ko = (size_t)(64 * (kt)) * ULD; LAS unsigned char* sp = lds + (st) * STAGE; \
        load_tile128<0>(Kg + ko, sp, wid, lane); load_tile128<1>(Vg + ko, sp + 16384, wid, lane); } while (0)
    SB_ISSUE(NT - 1, 0);
    const int qg = q0w + r;
    for (int ti = 0; ti < NT; ++ti) {
        const int kt = NT - 1 - ti;
        block_sync();
        if (ti > 0) { int alld = 1;
#pragma unroll
            for (int w = 0; w < 8; ++w) alld &= flags[((ti - 1) & 1) * 8 + w];
            if (alld) break; }
        if (ti + 1 < NT) SB_ISSUE(kt - 1, (ti + 1) & 1);
        int mydone = 0;
        if (64 * kt < q0w + 31) {
            if (!__all(R < -SB_CUT)) {
                const LAS unsigned char* sp = lds + (ti & 1) * STAGE;
                const bool masked = !(64 * kt + 63 < q0w);
#pragma unroll
                for (int kb = 1; kb >= 0; --kb) {
                    f32x16 x = qk_half_lq(sp + kb * 8192, qimg, r, h);
                    if (masked) sb_weights<true>(x, R, 64 * kt + 32 * kb, qg, h); else sb_weights<false>(x, R, 64 * kt + 32 * kb, qg, h);
                    pv_half<256>(o, x, sp + 16384, lane, kb);
                }
            }
            mydone = __all(R < -SB_CUT) ? 1 : 0;
        }
        if (lane == 0) flags[(ti & 1) * 8 + wid] = mydone;
    }
#undef SB_ISSUE
    bf16_t* orow = AO + (rowbase + q0w + r) * DM + 1024 + hd * 128 + 4 * h;
#pragma unroll
    for (int d = 0; d < 4; ++d)
#pragma unroll
        for (int g = 0; g < 4; ++g) { u32x2 w; w.x = cvtpk(o[d][4 * g], o[d][4 * g + 1]); w.y = cvtpk(o[d][4 * g + 2], o[d][4 * g + 3]); *(u32x2*)(orow + 32 * d + 8 * g) = w; }
    block_sync();
}
}

#define XB_TMO      128
#define XB_XCNT(j)  (256  + 64 * (j))
#define XB_XSUB(j)  (1280 + 64 * (j))
#define XB_XGEN(j)  (2304 + 64 * (j))
#define XB_TOP      3328
#define XB_TOPGEN   3392
#define XCD_BAR_WORDS 3456
#define XB_SPIN_CAP (1u << 18)

__device__ __forceinline__ unsigned xb_ld(unsigned* p)              { return __hip_atomic_load(p, __ATOMIC_RELAXED, __HIP_MEMORY_SCOPE_AGENT); }
__device__ __forceinline__ unsigned xb_add(unsigned* p, unsigned v) { return __hip_atomic_fetch_add(p, v, __ATOMIC_RELAXED, __HIP_MEMORY_SCOPE_AGENT); }
__device__ __forceinline__ unsigned xb_xcc_id() { return (unsigned)__builtin_amdgcn_s_getreg((3 << 11) | 20) & 0xFu; }
#define XB_SPIN(cond, bar) do { unsigned _sp = 0; while (cond) { __builtin_amdgcn_s_sleep(1); \
    if ((++_sp & 255u) == 0u) { if (xb_ld(&(bar)[XB_TMO])) break; if (_sp > XB_SPIN_CAP) { atomicAdd(&(bar)[XB_TMO], 1u); break; } } } } while (0)

struct XcdBarrier {
    unsigned* bar; unsigned x;
    volatile LAS unsigned* st;
};

__device__ __forceinline__ XcdBarrier xcd_barrier_post(unsigned* bar, volatile LAS unsigned* st) {
    XcdBarrier b; b.bar = bar; b.x = xb_xcc_id(); b.st = st;
    if (threadIdx.x == 0) (void)xb_add(&bar[XB_XCNT(b.x)], 1u);
    return b;
}
__device__ __forceinline__ void xcd_barrier_complete(unsigned* bar, unsigned x, unsigned& nloc, unsigned& nx) {
    const unsigned G = gridDim.x * gridDim.y * gridDim.z;
    unsigned sum, cnt, mine, sp = 0u;
    for (;;) {
        sum = 0u; cnt = 0u; mine = 0u;
#pragma unroll
        for (unsigned j = 0; j < 16; ++j) { const unsigned c = xb_ld(&bar[XB_XCNT(j)]); sum += c; cnt += (c > 0u) ? 1u : 0u; mine = (j == x) ? c : mine; }
        if (sum == G) break;
        __builtin_amdgcn_s_sleep(1);
        if ((++sp & 255u) == 0u) { if (xb_ld(&bar[XB_TMO])) break; if (sp > XB_SPIN_CAP) { atomicAdd(&bar[XB_TMO], 1u); break; } }
    }
    nloc = mine > 0u ? mine : 1u; nx = cnt > 0u ? cnt : 1u;
}

__device__ __forceinline__ void xcd_barrier(const XcdBarrier& b) {
    asm volatile("s_waitcnt vmcnt(0)" ::: "memory");
    __syncthreads();
    if (threadIdx.x == 0) {
        unsigned* bar = b.bar;
        __builtin_amdgcn_s_waitcnt(0);
        unsigned nloc = b.st[0], nx = b.st[1];
        if (nloc == 0u) { xcd_barrier_complete(bar, b.x, nloc, nx); b.st[0] = nloc; b.st[1] = nx; }
        const unsigned old = xb_add(&bar[XB_XSUB(b.x)], 1u);
        const unsigned gen = old / nloc;
        if (old + 1u == (gen + 1u) * nloc) {
            __builtin_amdgcn_fence(__ATOMIC_RELEASE, "agent");
            asm volatile("s_waitcnt vmcnt(0)" ::: "memory");
            const unsigned og = xb_add(&bar[XB_TOP], 1u);
            const unsigned tg = og / nx;
            if (og + 1u == (tg + 1u) * nx) xb_add(&bar[XB_TOPGEN], 1u);
            else XB_SPIN(xb_ld(&bar[XB_TOPGEN]) == tg, bar);
            __builtin_amdgcn_fence(__ATOMIC_ACQUIRE, "agent");
            xb_add(&bar[XB_XGEN(b.x)], 1u);
            asm volatile("s_waitcnt vmcnt(0)" ::: "memory");
        } else {
            XB_SPIN(xb_ld(&bar[XB_XGEN(b.x)]) == gen, bar);
            __builtin_amdgcn_fence(__ATOMIC_ACQUIRE, "agent");
            asm volatile("s_waitcnt vmcnt(0)" ::: "memory");
        }
    }
    __syncthreads();
}

struct Args { const float* in[20]; float* out; unsigned char* ws; };
enum { I_X = 0, I_N1, I_G1, I_U1, I_D1, I_NM, I_WIN, I_QN, I_KN, I_LQ1, I_LK1, I_LQ2, I_LK2, I_SUBLN, I_WOUT, I_N2, I_G2, I_U2, I_D2, I_NF };

__global__ void __launch_bounds__(NTHREADS, 2) fwd_megakernel(Args a) {
    extern __shared__ __attribute__((aligned(16))) unsigned char lds_raw[];
    LAS unsigned char* lds = (LAS unsigned char*)lds_raw;
    cg::grid_group grid = cg::this_grid();
    { volatile LAS unsigned* st0 = (volatile LAS unsigned*)(lds + MISC_OFF + 128); if (threadIdx.x == 0) { st0[0] = 0u; st0[1] = 0u; } __syncthreads(); }
    if (blockIdx.x == 0) for (int i = threadIdx.x; i < 16384; i += NTHREADS) ((unsigned*)(a.ws + WS_CTL))[i] = 0u;
#define GRID_BAR() xcd_barrier(xbar)
    const int G = gridDim.x, NGW = G * NWAVES;
    const int wid0 = __builtin_amdgcn_readfirstlane((int)threadIdx.x >> 6);
#define PHASE_IDS int lane = (int)__builtin_amdgcn_mbcnt_hi(~0u, __builtin_amdgcn_mbcnt_lo(~0u, 0u)); asm volatile("" : "+v"(lane)); const int wid = wid0, tid = wid * 64 + lane, gw = blockIdx.x * NWAVES + wid; (void)gw; (void)tid;
    unsigned char* ws = a.ws;
    unsigned* ctl = (unsigned*)(ws + WS_CTL);
    bf16_t* Wgu1 = (bf16_t*)(ws + WS_WGU1); bf16_t* Wd1 = (bf16_t*)(ws + WS_WD1); bf16_t* Win = (bf16_t*)(ws + WS_WIN); bf16_t* Wout = (bf16_t*)(ws + WS_WOUT);
    bf16_t* Wgu2 = (bf16_t*)(ws + WS_WGU2); bf16_t* Wd2 = (bf16_t*)(ws + WS_WD2);
    bf16_t* XN = (bf16_t*)(ws + WS_XN); bf16_t* BIG = (bf16_t*)(ws + WS_BIG);
    bf16_t* X1B = (bf16_t*)a.out; bf16_t* X2B = (bf16_t*)a.out + (size_t)M * DM;
    float* SSP = (float*)(ws + WS_SSP); LAS float* rsl = (LAS float*)(lds + pg8::RS_LDS_OFF);
    float* X = a.out;

    {
        PHASE_IDS
        LAS float* scr = (LAS float*)(lds + wid * 16384);
        constexpr int I_FF = (DM / 64) * (DFF / 32), I_DN = (DFF / 64) * (DM / 32), I_IN = (DM / 64) * (INC / 32), I_OUT = (DM / 64) * (DM / 32);
        constexpr int NITEMS = 4 * I_FF + 2 * I_DN + I_IN + I_OUT;
        for (int it = gw; it < NITEMS; it += NGW) {
            int r = it;
            if (r < I_FF) { transpose_item<false>(a.in[I_G1], DM, DFF, Wgu1, 1, 0, 0, 1.f, nullptr, scr, r, lane); continue; } r -= I_FF;
            if (r < I_FF) { transpose_item<false>(a.in[I_U1], DM, DFF, Wgu1, 2, 0, 0, 1.f, nullptr, scr, r, lane); continue; } r -= I_FF;
            if (r < I_DN) { transpose_item<false>(a.in[I_D1], DFF, DM, Wd1, 0, 0, 0, 1.f, nullptr, scr, r, lane); continue; } r -= I_DN;
            if (r < I_IN) { transpose_item<true>(a.in[I_WIN], DM, INC, Win, 0, 3072, 4096, QSCALE, a.in[I_NM], scr, r, lane); continue; } r -= I_IN;
            if (r < I_OUT) { transpose_item<false>(a.in[I_WOUT], DM, DM, Wout, 0, 0, 0, 1.f, nullptr, scr, r, lane); continue; } r -= I_OUT;
            if (r < I_FF) { transpose_item<true>(a.in[I_G2], DM, DFF, Wgu2, 1, 0, 0, 1.f, a.in[I_N2], scr, r, lane); continue; } r -= I_FF;
            if (r < I_FF) { transpose_item<true>(a.in[I_U2], DM, DFF, Wgu2, 2, 0, 0, 1.f, a.in[I_N2], scr, r, lane); continue; } r -= I_FF;
            transpose_item<false>(a.in[I_D2], DFF, DM, Wd2, 0, 0, 0, 1.f, nullptr, scr, r, lane);
        }
        rms_rows<false>(a.in[I_X], a.in[I_N1], XN, nullptr, gw, NGW, lane);
    }
    grid.sync();
    const XcdBarrier xbar = xcd_barrier_post((unsigned*)(a.ws + WS_CTL) + 4096, (volatile LAS unsigned*)(lds + MISC_OFF + 128));
    { pg8::Gemm g{XN, Wgu1, M, 2 * DFF, DM}; pg8::StaticOrder S; S.init(M, 2 * DFF, G, (int)blockIdx.x); pg8::EpiSwiGLU<false> E{BIG, DFF, rsl};
      pg8::gemm_phase<pg8::EpiSwiGLU<false>, pg8::StaticOrder, true, true>(lds, g, S, E, wid0); }
    GRID_BAR();
    { pg8::Gemm g{BIG, Wd1, M, DM, DFF}; pg8::StaticOrder S; S.init(M, DM, G, (int)blockIdx.x); typedef pg8::EpiResidB<false, 1, WS_SSP> Epi2; Epi2 E{a.in[I_X], X1B, DM, ws};
      pg8::gemm_phase<Epi2, pg8::StaticOrder, true, true>(lds, g, S, E, wid0); }
    GRID_BAR();
    { pg8::Gemm g{X1B, Win, M, INC, DM}; pg8::StaticOrder S; S.init(M, INC, G, (int)blockIdx.x); pg8::EpiBf16Rs E{BIG, INC, rsl};
      { PHASE_IDS pg8::Unit u0; if (S.next(0, u0)) build_rs(rsl, SSP, u0.pm & ~7, wid, lane); else block_sync(); }
      pg8::gemm_phase<pg8::EpiBf16Rs, pg8::StaticOrder, true, true>(lds, g, S, E, wid0); }
    GRID_BAR();
    { PHASE_IDS qknorm_rows(BIG, a.in[I_QN], a.in[I_KN], gw, NGW, lane); }
    GRID_BAR();
    {
        PHASE_IDS
        float lam;
        { const float p1 = a.in[I_LQ1][lane] * a.in[I_LK1][lane] + a.in[I_LQ1][lane + 64] * a.in[I_LK1][lane + 64];
          const float p2 = a.in[I_LQ2][lane] * a.in[I_LK2][lane] + a.in[I_LQ2][lane + 64] * a.in[I_LK2][lane + 64];
          lam = expf(wave_sum(p1, lane)) - expf(wave_sum(p2, lane)) + 0.2f; }
        volatile LAS int* sh = (volatile LAS int*)(lds + MISC_OFF);
        const int myx = (int)(__builtin_amdgcn_s_getreg((3 << 11) | 20) & 7u);
        for (int k = 0; k < 8; ++k) {
            const int qx = (myx + k) & 7; unsigned* cnt = ctl + 64 * (1 + qx);
            if (k == 1) { if (tid < 8) sh[8 + tid] = (int)__hip_atomic_load(ctl + 64 * (1 + tid), __ATOMIC_RELAXED, __HIP_MEMORY_SCOPE_AGENT); block_sync(); }
            if (k > 0 && sh[8 + qx] >= 128) continue;
            for (;;) {
                if (tid == 0) sh[0] = (int)atomicAdd(cnt, 1u);
                block_sync();
                const int idx = sh[0];
                block_sync();
                if (idx >= 128) break;
#ifndef NO_DIFF
                if (idx < 64) { const int sl = idx & 31, dbh = qx * 4 + 2 * (idx >> 5) + (sl >> 4), qi = sl & 15;
                    for (int rep = 0; rep < 2; ++rep) att::diff_unit(dbh, rep ? 31 - qi : qi, BIG, XN, a.in[I_SUBLN], lam, lds, wid, lane); }
#endif
#ifndef NO_SB
                if (idx >= 64) att::sb_unit(qx * 8 + ((idx - 64) >> 3), 7 - ((idx - 64) & 7), BIG, XN, lds, wid, lane);
#endif
            }
        }
    }
    GRID_BAR();
    { pg8::Gemm g{XN, Wout, M, DM, DM}; pg8::StaticOrder S; S.init(M, DM, G, (int)blockIdx.x); typedef pg8::EpiResidB<true, 2, WS_SSP + 2 * MiB> Epi4; Epi4 E{X1B, X2B, DM, ws};
      pg8::gemm_phase<Epi4, pg8::StaticOrder, true, true>(lds, g, S, E, wid0); }
    GRID_BAR();
    { pg8::Gemm g{X2B, Wgu2, M, 2 * DFF, DM}; pg8::StaticOrder S; S.init(M, 2 * DFF, G, (int)blockIdx.x); pg8::EpiSwiGLU<true> E{BIG, DFF, rsl};
      { PHASE_IDS pg8::Unit u0; if (S.next(0, u0)) build_rs(rsl, SSP + (size_t)M * 32, u0.pm & ~7, wid, lane); else block_sync(); }
      pg8::gemm_phase<pg8::EpiSwiGLU<true>, pg8::StaticOrder, true, true>(lds, g, S, E, wid0); }
    GRID_BAR();
    { pg8::Gemm g{BIG, Wd2, M, DM, DFF}; pg8::StaticOrder S; S.init(M, DM, G, (int)blockIdx.x); typedef pg8::EpiResidB<true, 1, WS_SSP + 4 * MiB> Epi6; Epi6 E{X2B, XN, DM, ws};
      pg8::gemm_phase<Epi6, pg8::StaticOrder, true, true>(lds, g, S, E, wid0); }
    GRID_BAR();
    { PHASE_IDS final_rows(X, XN, SSP + (size_t)M * 64, a.in[I_NF], gw, NGW, lane); }
}

extern "C" void kernel_launch(void* const* d_in, const int* in_sizes, int n_in, void* d_out, int out_size, void* d_ws, size_t ws_size, hipStream_t stream) {
    static int grid = 0;
    if (grid == 0) {
        if (n_in != 20 || out_size != M * DM || ws_size < WS_END) { fprintf(stderr, "kernel_launch: unexpected problem (n_in %d out %d ws %zu)\n", n_in, out_size, ws_size); grid = -1; return; }
        int dev = 0, cus = 0, per_cu = 0;
        (void)hipGetDevice(&dev); (void)hipDeviceGetAttribute(&cus, hipDeviceAttributeMultiprocessorCount, dev);
        (void)hipFuncSetAttribute((const void*)fwd_megakernel, hipFuncAttributeMaxDynamicSharedMemorySize, LDS_BYTES);
        (void)hipOccupancyMaxActiveBlocksPerMultiprocessor(&per_cu, (const void*)fwd_megakernel, NTHREADS, LDS_BYTES);
        if (per_cu < 1) { fprintf(stderr, "kernel_launch: occupancy query says %d blocks per CU\n", per_cu); per_cu = 1; }
        grid = cus * 1;
        (void)hipGetLastError();
    }
    if (grid < 0) return;
    Args a{};
    for (int i = 0; i < 20; ++i) a.in[i] = (const float*)d_in[i];
    a.out = (float*)d_out; a.ws = (unsigned char*)d_ws;
    void* args[] = {&a};
    hipError_t e = hipLaunchCooperativeKernel((const void*)fwd_megakernel, dim3(grid), dim3(NTHREADS), args, LDS_BYTES, stream);
    if (e != hipSuccess) fprintf(stderr, "cooperative launch failed: %s (grid %d)\n", hipGetErrorString(e), grid);
}
```

```cpp
#include <hip/hip_cooperative_groups.h>
#include <hip/hip_runtime.h>
#include <cstdio>
#include <cstdint>
namespace pg8 {
#define PG8_LAS __attribute__((address_space(3)))
typedef unsigned short bf16_t;
typedef short bf16x8 __attribute__((ext_vector_type(8)));
typedef float f32x4 __attribute__((ext_vector_type(4)));
typedef unsigned u32x4 __attribute__((ext_vector_type(4)));
constexpr int BM = 256, BK = 64, HALF = 128, HTB = HALF * BK * 2  , STAGE_BYTES = 8 * HTB, NXCD = 8, WGM = 8;

__host__ __device__ __forceinline__ int lds_byte(int r, int c) { const int st = (r >> 4) * 2 + (c >> 5), rr = r & 15, cc = c & 31, ob = rr * 64 + cc * 2; return st * 1024 + (ob ^ (((ob >> 9) & 1) << 5)); }
__host__ __device__ __forceinline__ void stage_rc(int b, int& R, int& C) { const int st = b / 1024, sb = b % 1024, swz = sb ^ (((sb >> 9) & 1) << 5); R = (st >> 1) * 16 + swz / 64; C = (st & 1) * 32 + (swz % 64) / 2; }
__host__ __device__ __forceinline__ int perm32(int rho) { const int n = rho >> 4, i = rho & 15; return 8 * (i >> 2) + 4 * n + (i & 3); }

struct Unit { int pm, pn; };
struct Gemm { const bf16_t* A; const bf16_t* Bt; int M, N, K; };

struct StaticOrder {
    int nM, nN, nwg, G, c;
    __host__ __device__ void init(int M, int N, int G_, int c_) { nM = M / BM; nN = N / BM; nwg = nM * nN; G = G_; c = c_; }
    __host__ __device__ bool next(int i, Unit& u) const {
        const long L = (long)i * G + c; if (L >= nwg) return false;
        int wgid = (int)L; { const int q = nwg / NXCD, r = nwg % NXCD, xcd = wgid % NXCD, off = wgid / NXCD; wgid = (xcd < r ? xcd * (q + 1) : r * (q + 1) + (xcd - r) * q) + off; }
        const int nig = WGM * nN, gid = wgid / nig, fm = gid * WGM, gsz = (nM - fm) < WGM ? (nM - fm) : WGM;
        u.pm = fm + ((wgid % nig) % gsz); u.pn = (wgid % nig) / gsz; return true;
    }
    __device__ __forceinline__ void a_ready(const Unit&) const {}
    __device__ __forceinline__ void done(const Unit&) const {}
};

__device__ __forceinline__ unsigned cvt_pk_bf16(float lo, float hi) { unsigned r; asm volatile("v_cvt_pk_bf16_f32 %0, %1, %2" : "=v"(r) : "v"(lo), "v"(hi)); return r; }
typedef float f32x2 __attribute__((ext_vector_type(2)));
__device__ __forceinline__ f32x2 gelu_pk(f32x2 v) {
    const f32x2 av = __builtin_elementwise_abs(v), d = av * 0.2316418882f + 1.0f;
    f32x2 t; t.x = __builtin_amdgcn_rcpf(d.x); t.y = __builtin_amdgcn_rcpf(d.y);
    f32x2 q = t * 0.5307027145f + (-0.7265760135f); q = q * t + 0.7107068705f; q = q * t + (-0.142248368f); q = q * t + 0.127414796f; q = q * t;
    const f32x2 s = (v * v) * (-0.72134752044f);
    f32x2 e; e.x = __builtin_amdgcn_exp2f(s.x); e.y = __builtin_amdgcn_exp2f(s.y);
    const f32x2 m = v * (q * e), r = v - m;
    f32x2 o; o.x = v.x < 0.f ? m.x : r.x; o.y = v.y < 0.f ? m.y : r.y; return o;
}

template <int ACT  > struct EpiBf16 {
    static constexpr bool PERM = true, AFTER_DRAIN = false; static_assert(ACT == 0 || ACT == 1, "EpiBf16: ACT is 0 (none) or 1 (gelu_pk)");
    bf16_t* O; int ldc; const float* bias; int split_cols; size_t split_stride; float scale0;
    __device__ __forceinline__ void operator()(const f32x4 (&acc)[2][2][4][2], const Unit& u, int wr, int wc, int fr, int fq) const {
        const int row0 = u.pm * BM + wr * 64 + fr; int colt = u.pn * BM; bf16_t* base = O;
        float sc = 1.f; if (split_cols) { const int t = colt / split_cols; base += (size_t)t * split_stride; colt -= t * split_cols; if (t == 0) sc = scale0; }
        const int col0 = colt + wc * 32 + 8 * fq, bcol0 = u.pn * BM + wc * 32 + 8 * fq;
        f32x4 bv[2][2];
#pragma unroll
        for (int bj = 0; bj < 2; ++bj)
#pragma unroll
            for (int n = 0; n < 2; ++n) bv[bj][n] = bias ? *(const f32x4*)(bias + bcol0 + bj * HALF + 4 * n) : (f32x4){0.f, 0.f, 0.f, 0.f};
#pragma unroll
        for (int ai = 0; ai < 2; ++ai)
#pragma unroll
            for (int m = 0; m < 4; ++m) { bf16_t* rowp = base + (size_t)(row0 + ai * HALF + m * 16) * ldc + col0;
#pragma unroll
                for (int bj = 0; bj < 2; ++bj) { f32x4 v0 = acc[ai][bj][m][0] + bv[bj][0], v1 = acc[ai][bj][m][1] + bv[bj][1];
                    if (ACT == 1) { f32x2 a = gelu_pk((f32x2){v0[0], v0[1]}), b = gelu_pk((f32x2){v0[2], v0[3]}), c = gelu_pk((f32x2){v1[0], v1[1]}), d = gelu_pk((f32x2){v1[2], v1[3]});
                        v0 = (f32x4){a.x, a.y, b.x, b.y}; v1 = (f32x4){c.x, c.y, d.x, d.y}; }
                    v0 = v0 * sc; v1 = v1 * sc; u32x4 w; w.x = cvt_pk_bf16(v0[0], v0[1]); w.y = cvt_pk_bf16(v0[2], v0[3]); w.z = cvt_pk_bf16(v1[0], v1[1]); w.w = cvt_pk_bf16(v1[2], v1[3]);
                    *(u32x4*)(rowp + bj * HALF) = w; } }
    }
};

template <class Epi, class Sched, bool ALIGN_EPI = false, bool SP2 = false>
__device__ __forceinline__ void gemm_phase(PG8_LAS unsigned char* lds, const Gemm g, const Sched S, const Epi E, int wid0) {
    int tid_ = wid0 * 64 + (int)__builtin_amdgcn_mbcnt_hi(~0u, __builtin_amdgcn_mbcnt_lo(~0u, 0u)); asm volatile("" : "+v"(tid_));
    const int tid = tid_, wid = __builtin_amdgcn_readfirstlane(tid >> 6), lane = tid & 63, wr = wid >> 2, wc = wid & 3, fr = lane & 15, fq = lane >> 4;
    const int K = g.K, nt = K / BK;
    unsigned voffA[2], voffB[2];
#pragma unroll
    for (int i = 0; i < 2; ++i) { int R, C; stage_rc(tid * 16 + i * 8192, R, C); const int Rb = Epi::PERM ? ((R & ~31) + perm32(R & 31)) : R;
        voffA[i] = (unsigned)(R * K + C) * 2u; voffB[i] = (unsigned)(Rb * K + C) * 2u; }
    const size_t kstep = (size_t)(BK * 2);
    const size_t hstep = (size_t)HALF * K * 2;
    const size_t tstep = 2 * hstep;
    const unsigned ldsw = (unsigned)wid * 1024u;
    const int aoff = lds_byte(wr * 64 + fr, fq * 8), boff = lds_byte(wc * 32 + fr, fq * 8);
#define PG8_SA(b, h) (((b) * 2 + (h)) * HTB)
#define PG8_SB(b, h) ((4 + (b) * 2 + (h)) * HTB)
#define PG8_STAGE(bufoff, gbase, voff) do { _Pragma("unroll") for (int _i = 0; _i < 2; ++_i) \
        __builtin_amdgcn_global_load_lds((const unsigned*)((const char*)(gbase) + (voff)[_i]), (PG8_LAS unsigned*)(lds + (bufoff) + ldsw + _i * 8192), 16, 0, 0); } while (0)
#define PG8_LDA(dst, b, h) do { _Pragma("unroll") for (int m = 0; m < 4; ++m) _Pragma("unroll") for (int k = 0; k < 2; ++k) dst[m][k] = *(const PG8_LAS bf16x8*)(lds + PG8_SA(b, h) + aoff + m * 2048 + k * 1024); } while (0)
#define PG8_LDB(dst, b, h) do { _Pragma("unroll") for (int n = 0; n < 2; ++n) _Pragma("unroll") for (int k = 0; k < 2; ++k) dst[n][k] = *(const PG8_LAS bf16x8*)(lds + PG8_SB(b, h) + boff + n * 2048 + k * 1024); } while (0)
#define PG8_MMA(ai, bj, At, Bt) do { __builtin_amdgcn_s_setprio(1); _Pragma("unroll") for (int m = 0; m < 4; ++m) _Pragma("unroll") for (int n = 0; n < 2; ++n) _Pragma("unroll") for (int k = 0; k < 2; ++k) \
        acc[ai][bj][m][n] = __builtin_amdgcn_mfma_f32_16x16x32_bf16(Bt[n][k], At[m][k], acc[ai][bj][m][n], 0, 0, 0); __builtin_amdgcn_s_setprio(0); } while (0)
#define PG8_WAIT_V(n) asm volatile("s_waitcnt vmcnt(" #n ")" ::: "memory")
#define PG8_WAIT_L(n) asm volatile("s_waitcnt lgkmcnt(" #n ")" ::: "memory")
#define PG8_BAR __builtin_amdgcn_s_barrier()
#define PG8_SCHED __builtin_amdgcn_sched_barrier(0)
    Unit cur, nxt; int ui = 0;
    if (!S.next(0, cur)) return;
    f32x4 acc[2][2][4][2];
#pragma unroll
    for (int a = 0; a < 2; ++a)
#pragma unroll
        for (int b = 0; b < 2; ++b)
#pragma unroll
            for (int m = 0; m < 4; ++m)
#pragma unroll
                for (int n = 0; n < 2; ++n) acc[a][b][m][n] = (f32x4){0.f, 0.f, 0.f, 0.f};
    bf16x8 At[4][2], B0[2][2], B1[2][2];
    const char* cA = (const char*)g.A + (size_t)cur.pm * tstep; const char* cB = (const char*)g.Bt + (size_t)cur.pn * tstep;
    S.a_ready(cur);
    if constexpr (SP2) {
        PG8_STAGE(PG8_SB(0, 0), cB, voffB); PG8_STAGE(PG8_SB(0, 1), cB + hstep, voffB); PG8_STAGE(PG8_SA(0, 0), cA, voffA); PG8_STAGE(PG8_SA(0, 1), cA + hstep, voffA);
        if (wr == 1) PG8_BAR;
        PG8_WAIT_V(2); PG8_BAR;
        PG8_STAGE(PG8_SB(1, 0), cB + kstep, voffB); PG8_STAGE(PG8_SA(1, 0), cA + kstep, voffA); PG8_STAGE(PG8_SB(1, 1), cB + hstep + kstep, voffB);
        PG8_WAIT_V(6); PG8_BAR;
    } else {
        PG8_STAGE(PG8_SB(0, 0), cB, voffB); PG8_STAGE(PG8_SA(0, 0), cA, voffA); PG8_STAGE(PG8_SB(0, 1), cB + hstep, voffB); PG8_STAGE(PG8_SA(0, 1), cA + hstep, voffA);
        if (wr == 1) PG8_BAR;
        PG8_WAIT_V(4); PG8_BAR;
        PG8_STAGE(PG8_SB(1, 0), cB + kstep, voffB); PG8_STAGE(PG8_SA(1, 0), cA + kstep, voffA); PG8_STAGE(PG8_SB(1, 1), cB + hstep + kstep, voffB);
        PG8_WAIT_V(6); PG8_BAR;
    }
    for (;;) {
        const bool has_next = S.next(ui + 1, nxt);
        const char* nA = has_next ? (const char*)g.A + (size_t)nxt.pm * tstep : cA; const char* nB = has_next ? (const char*)g.Bt + (size_t)nxt.pn * tstep : cB;
        for (int t = 0; t < nt; t += 2) {
            const bool last = (t == nt - 2);
            const char* a1 = cA + (size_t)(t + 1) * kstep;
            const char* a2 = last ? nA : cA + (size_t)(t + 2) * kstep; const char* b2 = last ? nB : cB + (size_t)(t + 2) * kstep;
            const char* a3 = a2 + kstep; const char* b3 = b2 + kstep;
            if (last && has_next) S.a_ready(nxt);
            if constexpr (SP2) {
            PG8_LDB(B0, 0, 0); PG8_LDB(B1, 0, 1); PG8_SCHED; PG8_LDA(At, 0, 0); PG8_STAGE(PG8_SA(1, 1), a1 + hstep, voffA);
            PG8_WAIT_V(8); PG8_WAIT_L(0); PG8_BAR; PG8_MMA(0, 0, At, B0); PG8_MMA(0, 1, At, B1); PG8_BAR; PG8_SCHED;
            PG8_LDA(At, 0, 1); PG8_STAGE(PG8_SB(0, 0), b2, voffB); PG8_STAGE(PG8_SB(0, 1), b2 + hstep, voffB); PG8_STAGE(PG8_SA(0, 0), a2, voffA);
            PG8_WAIT_V(8); PG8_WAIT_L(0); PG8_BAR; PG8_MMA(1, 0, At, B0); PG8_MMA(1, 1, At, B1); PG8_BAR; PG8_SCHED;
            PG8_LDB(B0, 1, 0); PG8_LDB(B1, 1, 1); PG8_SCHED; PG8_LDA(At, 1, 0); PG8_STAGE(PG8_SA(0, 1), a2 + hstep, voffA);
            PG8_WAIT_V(8); PG8_WAIT_L(0); PG8_BAR; PG8_MMA(0, 0, At, B0); PG8_MMA(0, 1, At, B1); PG8_BAR; PG8_SCHED;
            PG8_LDA(At, 1, 1); PG8_STAGE(PG8_SB(1, 0), b3, voffB); PG8_STAGE(PG8_SB(1, 1), b3 + hstep, voffB); PG8_STAGE(PG8_SA(1, 0), a3, voffA);
            PG8_WAIT_V(8); PG8_WAIT_L(0); PG8_BAR; PG8_MMA(1, 0, At, B0); PG8_MMA(1, 1, At, B1); PG8_BAR; PG8_SCHED;
            } else {
            PG8_LDB(B0, 0, 0); PG8_SCHED; PG8_LDA(At, 0, 0); PG8_STAGE(PG8_SA(1, 1), a1 + hstep, voffA);
            PG8_WAIT_L(8); PG8_BAR; PG8_WAIT_L(0); PG8_MMA(0, 0, At, B0); PG8_BAR; PG8_SCHED;
            PG8_LDB(B1, 0, 1); PG8_STAGE(PG8_SB(0, 0), b2, voffB);
            PG8_BAR; PG8_WAIT_L(0); PG8_MMA(0, 1, At, B1); PG8_BAR;
            PG8_LDA(At, 0, 1); PG8_STAGE(PG8_SA(0, 0), a2, voffA);
            PG8_BAR; PG8_WAIT_L(0); PG8_MMA(1, 0, At, B0); PG8_BAR; PG8_SCHED;
            PG8_STAGE(PG8_SB(0, 1), b2 + hstep, voffB);
            PG8_WAIT_V(6); PG8_BAR; PG8_MMA(1, 1, At, B1); PG8_BAR;
            PG8_LDB(B0, 1, 0); PG8_SCHED; PG8_LDA(At, 1, 0); PG8_STAGE(PG8_SA(0, 1), a2 + hstep, voffA);
            PG8_WAIT_L(8); PG8_BAR; PG8_WAIT_L(0); PG8_MMA(0, 0, At, B0); PG8_BAR; PG8_SCHED;
            PG8_LDB(B1, 1, 1); PG8_STAGE(PG8_SB(1, 0), b3, voffB);
            PG8_BAR; PG8_WAIT_L(0); PG8_MMA(0, 1, At, B1); PG8_BAR;
            PG8_LDA(At, 1, 1); PG8_STAGE(PG8_SA(1, 0), a3, voffA);
            PG8_BAR; PG8_WAIT_L(0); PG8_MMA(1, 0, At, B0); PG8_BAR; PG8_SCHED;
            PG8_STAGE(PG8_SB(1, 1), b3 + hstep, voffB);
            PG8_WAIT_V(6); PG8_BAR; PG8_MMA(1, 1, At, B1); PG8_BAR;
            }
        }
        if constexpr (ALIGN_EPI) { if (wr == 0) PG8_BAR; }
        if constexpr (!Epi::AFTER_DRAIN) { E(acc, cur, wr, wc, fr, fq); S.done(cur); }
        if (!has_next) break;
#pragma unroll
        for (int a = 0; a < 2; ++a)
#pragma unroll
            for (int b = 0; b < 2; ++b)
#pragma unroll
                for (int m = 0; m < 4; ++m)
#pragma unroll
                    for (int n = 0; n < 2; ++n) acc[a][b][m][n] = (f32x4){0.f, 0.f, 0.f, 0.f};
        cur = nxt; cA = nA; cB = nB; ++ui;
        if constexpr (ALIGN_EPI) { if (wr == 1) PG8_BAR; }
    }
    PG8_WAIT_V(0);
    if constexpr (!ALIGN_EPI) { if (wr == 0) PG8_BAR; }
    PG8_BAR;
    if constexpr (Epi::AFTER_DRAIN) { E.fused(acc, cur, wr, wc, fr, fq, lds, wid, lane); S.done(cur); }
#undef PG8_SA
#undef PG8_SB
#undef PG8_STAGE
#undef PG8_LDA
#undef PG8_LDB
#undef PG8_MMA
#undef PG8_WAIT_V
#undef PG8_WAIT_L
#undef PG8_BAR
#undef PG8_SCHED
}
}
namespace pg8 {
constexpr int RS_LDS_OFF = 131072 + 1024;
__device__ __forceinline__ float bflo(unsigned w) { return __uint_as_float(w << 16); }
__device__ __forceinline__ float bfhi(unsigned w) { return __uint_as_float(w & 0xffff0000u); }
template <bool HAS_RS> struct EpiSwiGLU {
    static constexpr bool PERM = true, AFTER_DRAIN = false;
    bf16_t* O; int ldc; PG8_LAS const float* rsl;
    __device__ __forceinline__ void operator()(const f32x4 (&acc)[2][2][4][2], const Unit& u, int wr, int wc, int fr, int fq) const {
        const int row0 = u.pm * BM + wr * 64 + fr; const int col0 = u.pn * HALF + wc * 32 + 8 * fq;
        float rsv[2][4];
#pragma unroll
        for (int ai = 0; ai < 2; ++ai)
#pragma unroll
            for (int m = 0; m < 4; ++m) rsv[ai][m] = HAS_RS ? rsl[(u.pm & 7) * 256 + wr * 64 + ai * HALF + m * 16 + fr] : 1.0f;
#pragma unroll
        for (int ai = 0; ai < 2; ++ai)
#pragma unroll
            for (int m = 0; m < 4; ++m) { bf16_t* rowp = O + (size_t)(row0 + ai * HALF + m * 16) * ldc + col0; const float rs = rsv[ai][m];
                float hv[8];
#pragma unroll
                for (int n = 0; n < 2; ++n)
#pragma unroll
                    for (int e = 0; e < 4; ++e) { const float g = acc[ai][0][m][n][e] * rs, up = acc[ai][1][m][n][e] * rs;
                        const float ex = __builtin_amdgcn_exp2f(-g * 1.4426950408889634f);
                        hv[n * 4 + e] = g * __builtin_amdgcn_rcpf(1.0f + ex) * up; }
                u32x4 w; w.x = cvt_pk_bf16(hv[0], hv[1]); w.y = cvt_pk_bf16(hv[2], hv[3]); w.z = cvt_pk_bf16(hv[4], hv[5]); w.w = cvt_pk_bf16(hv[6], hv[7]);
                *(u32x4*)rowp = w; }
    }
};
struct EpiBf16Rs {
    static constexpr bool PERM = true, AFTER_DRAIN = false;
    bf16_t* O; int ldc; PG8_LAS const float* rsl;
    __device__ __forceinline__ void operator()(const f32x4 (&acc)[2][2][4][2], const Unit& u, int wr, int wc, int fr, int fq) const {
        const int row0 = u.pm * BM + wr * 64 + fr; const int col0 = u.pn * BM + wc * 32 + 8 * fq;
        float rsv[2][4];
#pragma unroll
        for (int ai = 0; ai < 2; ++ai)
#pragma unroll
            for (int m = 0; m < 4; ++m) rsv[ai][m] = rsl[(u.pm & 7) * 256 + wr * 64 + ai * HALF + m * 16 + fr];
#pragma unroll
        for (int ai = 0; ai < 2; ++ai)
#pragma unroll
            for (int m = 0; m < 4; ++m) { bf16_t* rowp = O + (size_t)(row0 + ai * HALF + m * 16) * ldc + col0; const float rs = rsv[ai][m];
#pragma unroll
                for (int bj = 0; bj < 2; ++bj) { const f32x4 v0 = acc[ai][bj][m][0] * rs, v1 = acc[ai][bj][m][1] * rs;
                    u32x4 w; w.x = cvt_pk_bf16(v0[0], v0[1]); w.y = cvt_pk_bf16(v0[2], v0[3]); w.z = cvt_pk_bf16(v1[0], v1[1]); w.w = cvt_pk_bf16(v1[2], v1[3]);
                    *(u32x4*)(rowp + bj * HALF) = w; } }
    }
};
struct EpiQKV {
    static constexpr bool PERM = true, AFTER_DRAIN = false;
    bf16_t* O; PG8_LAS float* rsl; const float* qn; const float* kn;
    __device__ __forceinline__ void operator()(const f32x4 (&acc)[2][2][4][2], const Unit& u, int wr, int wc, int fr, int fq) const {
        constexpr int ldc = 6144; constexpr float QS = 0.08838834764831845f * 1.4426950408889634f;
        const int rl0 = wr * 64 + fr, row0 = u.pm * BM + rl0, col0 = u.pn * BM + wc * 32 + 8 * fq, lane = fr + 16 * fq;
        float rsv[2][4];
#pragma unroll
        for (int ai = 0; ai < 2; ++ai)
#pragma unroll
            for (int m = 0; m < 4; ++m) rsv[ai][m] = rsl[(u.pm & 7) * 256 + rl0 + ai * HALF + m * 16];
        if (u.pn >= 8) {
#pragma unroll
            for (int ai = 0; ai < 2; ++ai)
#pragma unroll
                for (int m = 0; m < 4; ++m) { bf16_t* rowp = O + (size_t)(row0 + ai * HALF + m * 16) * ldc + col0; const float rs = rsv[ai][m];
#pragma unroll
                    for (int bj = 0; bj < 2; ++bj) { const f32x4 v0 = acc[ai][bj][m][0] * rs, v1 = acc[ai][bj][m][1] * rs;
                        u32x4 w; w.x = cvt_pk_bf16(v0[0], v0[1]); w.y = cvt_pk_bf16(v0[2], v0[3]); w.z = cvt_pk_bf16(v1[0], v1[1]); w.w = cvt_pk_bf16(v1[2], v1[3]);
                        *(u32x4*)(rowp + bj * HALF) = w; } }
            return;
        }
        PG8_LAS float* xs = rsl + 2048;
#pragma unroll
        for (int ai = 0; ai < 2; ++ai)
#pragma unroll
            for (int m = 0; m < 4; ++m) { const float rs = rsv[ai][m];
#pragma unroll
                for (int bj = 0; bj < 2; ++bj) { const f32x4 v0 = acc[ai][bj][m][0] * rs, v1 = acc[ai][bj][m][1] * rs;
                    float sq = ((v0[0] * v0[0] + v0[1] * v0[1]) + (v0[2] * v0[2] + v0[3] * v0[3])) + ((v1[0] * v1[0] + v1[1] * v1[1]) + (v1[2] * v1[2] + v1[3] * v1[3]));
                    sq += __int_as_float(__builtin_amdgcn_ds_bpermute((lane ^ 16) << 2, __float_as_int(sq))); sq += __int_as_float(__builtin_amdgcn_ds_bpermute((lane ^ 32) << 2, __float_as_int(sq)));
                    if (fq == 0) xs[((rl0 + ai * HALF + m * 16) * 2 + bj) * 4 + wc] = sq; } }
        asm volatile("s_waitcnt lgkmcnt(0)" ::: "memory"); __builtin_amdgcn_s_barrier(); asm volatile("" ::: "memory");
        const bool isq = u.pn < 4;
        const float* gp = (isq ? qn : kn) + wc * 32 + 8 * fq;
        const f32x4 g0 = *(const f32x4*)gp, g1 = *(const f32x4*)(gp + 4);
        const float qs = isq ? QS : 1.0f, sgn = (fq < 2) ? -1.0f : 1.0f;
        float invf[8];
#pragma unroll
        for (int e = 0; e < 8; ++e) invf[e] = __builtin_amdgcn_exp2f(-(float)(8 * (fq & 1) + e) * (18.931568569324174f / 16.0f));
#pragma unroll
        for (int ai = 0; ai < 2; ++ai)
#pragma unroll
            for (int m = 0; m < 4; ++m) { const int rl = rl0 + ai * HALF + m * 16, row = u.pm * BM + rl; const float rs = rsv[ai][m];
                float cs[8], sn[8];
                if (wc == 0) { const float pos = (float)(row & 2047);
#pragma unroll
                    for (int e = 0; e < 8; ++e) { const float ang = pos * invf[e]; const float nr = __builtin_rintf(ang * 0.15915494309189535f);
                        float rr_ = __builtin_fmaf(-nr, 6.28318548202514648f, ang); rr_ = __builtin_fmaf(-nr, -1.74845553146951715e-7f, rr_); const float fr_ = rr_ * 0.15915494309189535f;
                        cs[e] = __builtin_amdgcn_cosf(fr_); sn[e] = __builtin_amdgcn_sinf(fr_); } }
#pragma unroll
                for (int bj = 0; bj < 2; ++bj) { const f32x4 pp = *(const PG8_LAS f32x4*)(xs + (rl * 2 + bj) * 4);
                    const float k = rs * qs / sqrtf(((pp[0] + pp[1]) + (pp[2] + pp[3])) * (1.0f / 128.0f) + 1e-5f);
                    float y[8];
#pragma unroll
                    for (int e = 0; e < 8; ++e) y[e] = acc[ai][bj][m][e >> 2][e & 3] * (e < 4 ? g0[e] : g1[e - 4]);
                    if (wc == 0) {
#pragma unroll
                        for (int e = 0; e < 8; ++e) { auto rr = __builtin_amdgcn_permlane32_swap(__float_as_uint(y[e]), __float_as_uint(y[e]), false, false);
                            const float yp = __uint_as_float((fq >> 1) ? rr[0] : rr[1]); y[e] = y[e] * cs[e] + sgn * yp * sn[e]; } }
                    u32x4 w; w.x = cvt_pk_bf16(y[0] * k, y[1] * k); w.y = cvt_pk_bf16(y[2] * k, y[3] * k); w.z = cvt_pk_bf16(y[4] * k, y[5] * k); w.w = cvt_pk_bf16(y[6] * k, y[7] * k);
                    *(u32x4*)(O + (size_t)row * ldc + col0 + bj * HALF) = w; } }
    }
};
template <bool BASE_BF16, int ALPHA_X2, size_t SS_OFF> struct EpiResidB {
    static constexpr bool PERM = true, AFTER_DRAIN = false;
    const void* base; bf16_t* out; int ldc; unsigned char* wsb;
    __device__ __forceinline__ void operator()(const f32x4 (&acc)[2][2][4][2], const Unit& u, int wr, int wc, int fr, int fq) const {
        const int row0 = u.pm * BM + wr * 64 + fr; const int col0 = u.pn * BM + wc * 32 + 8 * fq; const int lane = fr + 16 * fq; constexpr float alpha = 0.5f * ALPHA_X2;
        float* ssp = (float*)(wsb + SS_OFF);
#pragma unroll
        for (int ai = 0; ai < 2; ++ai) {
            u32x4 bb[4][2]; f32x4 bf[4][2][2];
#pragma unroll
            for (int m = 0; m < 4; ++m) { const size_t ro = (size_t)(row0 + ai * HALF + m * 16) * ldc + col0;
#pragma unroll
                for (int bj = 0; bj < 2; ++bj) {
                    if (BASE_BF16) bb[m][bj] = *(const u32x4*)((const bf16_t*)base + ro + bj * HALF);
                    else { bf[m][bj][0] = *(const f32x4*)((const float*)base + ro + bj * HALF); bf[m][bj][1] = *(const f32x4*)((const float*)base + ro + bj * HALF + 4); } } }
            asm volatile("" ::: "memory");
#pragma unroll
            for (int m = 0; m < 4; ++m) { const int row = row0 + ai * HALF + m * 16; const size_t ro = (size_t)row * ldc + col0; float sq = 0.f;
#pragma unroll
                for (int bj = 0; bj < 2; ++bj) { f32x4 b0, b1;
                    if (BASE_BF16) { const u32x4 w = bb[m][bj]; b0 = (f32x4){bflo(w.x), bfhi(w.x), bflo(w.y), bfhi(w.y)}; b1 = (f32x4){bflo(w.z), bfhi(w.z), bflo(w.w), bfhi(w.w)}; }
                    else { b0 = bf[m][bj][0]; b1 = bf[m][bj][1]; }
                    const f32x4 v0 = b0 + acc[ai][bj][m][0] * alpha, v1 = b1 + acc[ai][bj][m][1] * alpha;
                    sq += ((v0[0] * v0[0] + v0[1] * v0[1]) + (v0[2] * v0[2] + v0[3] * v0[3])) + ((v1[0] * v1[0] + v1[1] * v1[1]) + (v1[2] * v1[2] + v1[3] * v1[3]));
                    u32x4 o; o.x = cvt_pk_bf16(v0[0], v0[1]); o.y = cvt_pk_bf16(v0[2], v0[3]); o.z = cvt_pk_bf16(v1[0], v1[1]); o.w = cvt_pk_bf16(v1[2], v1[3]);
                    *(u32x4*)(out + ro + bj * HALF) = o; }
                sq += __int_as_float(__builtin_amdgcn_ds_bpermute((lane ^ 16) << 2, __float_as_int(sq))); sq += __int_as_float(__builtin_amdgcn_ds_bpermute((lane ^ 32) << 2, __float_as_int(sq)));
                if (fq == 0) ssp[(size_t)row * 32 + u.pn * 4 + wc] = sq; }
            asm volatile("" ::: "memory");
        }
    }
};
}

namespace cg = cooperative_groups;
#define LAS __attribute__((address_space(3)))
#define DI __device__ __forceinline__
typedef unsigned short bf16_t;
typedef short bf16x8 __attribute__((ext_vector_type(8)));
typedef short s16x4 __attribute__((ext_vector_type(4)));
typedef float f32x4 __attribute__((ext_vector_type(4)));
typedef float f32x2 __attribute__((ext_vector_type(2)));
typedef float f32x16 __attribute__((ext_vector_type(16)));
typedef unsigned u32x4 __attribute__((ext_vector_type(4)));
typedef unsigned u32x2 __attribute__((ext_vector_type(2)));
typedef __bf16 bf16x2_t __attribute__((ext_vector_type(2)));

constexpr int BATCH = 8, SEQ = 2048, DM = 2048, DFF = 5632, INC = 6144, M = BATCH * SEQ;
constexpr float EPS = 1e-5f;
constexpr float LOG2E = 1.4426950408889634f;
constexpr float QSCALE = 0.08838834764831845f * LOG2E;
constexpr int NWAVES = 8, NTHREADS = 512;

constexpr size_t MiB = 1u << 20;
constexpr size_t WS_CTL = 0;
constexpr size_t WS_WGU1 = 1 * MiB, WS_WD1 = 45 * MiB, WS_WIN = 67 * MiB, WS_WOUT = 91 * MiB, WS_WGU2 = 99 * MiB, WS_WD2 = 143 * MiB;
constexpr size_t WS_XN = 166 * MiB;
constexpr size_t WS_BIG = 230 * MiB;
constexpr size_t WS_SSP = 422 * MiB;
constexpr size_t WS_END = 428 * MiB;
constexpr int RING_BYTES = 131072, MISC_OFF = RING_BYTES, LDS_BYTES = RING_BYTES + 1024 + 8192 + 8192;

DI unsigned cvtpk(float lo, float hi) { f32x2 v = {lo, hi}; bf16x2_t b = __builtin_convertvector(v, bf16x2_t); return __builtin_bit_cast(unsigned, b); }
DI float bf2f(unsigned short s) { return __uint_as_float((unsigned)s << 16); }
DI float shx(float v, int o, int lane) { return __int_as_float(__builtin_amdgcn_ds_bpermute((lane ^ o) << 2, __float_as_int(v))); }
DI float swap32(float v, int h) { auto rr = __builtin_amdgcn_permlane32_swap(__float_as_uint(v), __float_as_uint(v), false, false); return __uint_as_float(h ? rr[0] : rr[1]); }
DI float wave_sum(float v, int lane) {
#pragma unroll
    for (int o = 1; o < 64; o <<= 1) v += shx(v, o, lane);
    return v;
}
DI void block_sync() { asm volatile("s_waitcnt vmcnt(0) lgkmcnt(0)" ::: "memory"); __builtin_amdgcn_s_barrier(); asm volatile("" ::: "memory"); }

template <bool HAS_GAIN> DI void transpose_item(const float* __restrict__ W, int K, int N, bf16_t* __restrict__ WT, int mode, int slo, int shi, float scale, const float* __restrict__ kgain, LAS float* scr, int item, int lane) {
    asm volatile("" : "+v"(lane));
    const int nblk = N / 32, kb = item / nblk, nb = item % nblk, k0 = 64 * kb, n0 = 32 * nb;
    float gvec = 1.0f; if (HAS_GAIN) gvec = kgain[k0 + lane];
#pragma unroll 8
    for (int i = 0; i < 32; ++i) { const int kk = 2 * i + (lane >> 5); float wv = W[(size_t)(k0 + kk) * N + n0 + (lane & 31)];
        if (HAS_GAIN) { const float g0 = __uint_as_float(__builtin_amdgcn_readlane(__float_as_uint(gvec), 2 * i)), g1 = __uint_as_float(__builtin_amdgcn_readlane(__float_as_uint(gvec), 2 * i + 1)); wv *= (lane >> 5) ? g1 : g0; }
        scr[kk * 33 + (lane & 31)] = wv; }
    asm volatile("s_waitcnt lgkmcnt(0)" ::: "memory");
    const int c = lane & 7;
    const float sc = (n0 >= slo && n0 < shi) ? scale : 1.0f;
    const int rbase = mode == 0 ? n0 : ((n0 >> 7) * 256 + (n0 & 127) + (mode == 2 ? 128 : 0));
#pragma unroll
    for (int j = 0; j < 4; ++j) { const int n = (lane >> 3) + 8 * j; const LAS float* s = scr + (8 * c) * 33 + n;
        u32x4 o; o.x = cvtpk(s[0 * 33] * sc, s[1 * 33] * sc); o.y = cvtpk(s[2 * 33] * sc, s[3 * 33] * sc); o.z = cvtpk(s[4 * 33] * sc, s[5 * 33] * sc); o.w = cvtpk(s[6 * 33] * sc, s[7 * 33] * sc);
        *(u32x4*)(WT + (size_t)(rbase + n) * K + k0 + 8 * c) = o; }
    asm volatile("s_waitcnt lgkmcnt(0)" ::: "memory");
}

template <bool F32OUT> DI void rms_rows(const float* src, const float* __restrict__ gain, bf16_t* dstb, float* dstf, int gw, int NGW, int lane) {
    asm volatile("" : "+v"(lane));
    for (int m = gw; m < M; m += NGW) {
        const f32x4* xr = (const f32x4*)(src + (size_t)m * DM) + lane;
        f32x4 v[8]; float s = 0.f;
#pragma unroll
        for (int j = 0; j < 8; ++j) { v[j] = xr[64 * j]; s += (v[j].x * v[j].x + v[j].y * v[j].y) + (v[j].z * v[j].z + v[j].w * v[j].w); }
        const float rstd = 1.0f / sqrtf(wave_sum(s, lane) * (1.0f / DM) + EPS);
#pragma unroll
        for (int j = 0; j < 8; ++j) { const f32x4 g = ((const f32x4*)gain)[lane + 64 * j]; const f32x4 y = v[j] * rstd * g;
            if (F32OUT) ((f32x4*)(dstf + (size_t)m * DM))[lane + 64 * j] = y;
            else { u32x2 w; w.x = cvtpk(y.x, y.y); w.y = cvtpk(y.z, y.w); ((u32x2*)(dstb + (size_t)m * DM))[lane + 64 * j] = w; } }
    }
}

DI void build_rs(LAS float* rsl, const float* __restrict__ ssp, int fm, int wid, int lane) {
    asm volatile("" : "+v"(lane));
#pragma unroll 2
    for (int k = 0; k < 8; ++k) { const int rl = wid * 32 + (lane >> 1); const f32x4* p = (const f32x4*)(ssp + ((size_t)(fm + k) * 256 + rl) * 32 + (lane & 1) * 16);
        const f32x4 a = p[0], b = p[1], c = p[2], d = p[3]; float sm = ((a.x + a.y) + (a.z + a.w)) + ((b.x + b.y) + (b.z + b.w)) + ((c.x + c.y) + (c.z + c.w)) + ((d.x + d.y) + (d.z + d.w));
        sm += shx(sm, 1, lane);
        if ((lane & 1) == 0) rsl[k * 256 + rl] = 1.0f / sqrtf(sm * (1.0f / DM) + EPS); }
    block_sync();
}
DI void final_rows(float* __restrict__ out, const bf16_t* __restrict__ xb, const float* __restrict__ ssp, const float* __restrict__ gain, int gw, int NGW, int lane) {
    asm volatile("" : "+v"(lane));
    for (int m = gw; m < M; m += NGW) {
        const u32x4* xr = (const u32x4*)(xb + (size_t)m * DM) + lane;
        u32x4 raw[4];
#pragma unroll
        for (int j = 0; j < 4; ++j) raw[j] = xr[64 * j];
        const float rstd = 1.0f / sqrtf(wave_sum(lane < 32 ? ssp[(size_t)m * 32 + lane] : 0.f, lane) * (1.0f / DM) + EPS);
        f32x4* orow = (f32x4*)(out + (size_t)m * DM);
#pragma unroll
        for (int j = 0; j < 4; ++j) { const int c8 = lane + 64 * j; const f32x4 g0 = ((const f32x4*)gain)[2 * c8], g1 = ((const f32x4*)gain)[2 * c8 + 1]; const u32x4 w = raw[j];
            f32x4 y0 = {__uint_as_float(w.x << 16), __uint_as_float(w.x & 0xffff0000u), __uint_as_float(w.y << 16), __uint_as_float(w.y & 0xffff0000u)};
            f32x4 y1 = {__uint_as_float(w.z << 16), __uint_as_float(w.z & 0xffff0000u), __uint_as_float(w.w << 16), __uint_as_float(w.w & 0xffff0000u)};
            orow[2 * c8] = y0 * rstd * g0; orow[2 * c8 + 1] = y1 * rstd * g1; }
    }
}

DI void qknorm_rows(bf16_t* U, const float* __restrict__ qn, const float* __restrict__ kn, int gw, int NGW, int lane) {
    asm volatile("" : "+v"(lane));
    const int cw = lane & 15;
    for (int m = gw; m < M; m += NGW) {
        const int pos = m & (SEQ - 1);
        float cs[8], sn[8];
        if (cw < 4) {
#pragma unroll
            for (int e = 0; e < 8; ++e) { const int fi = 8 * (cw & 1) + e;
                const float invf = exp2f(-(float)fi * (18.931568569324174f / 16.0f));
                const float ang = (float)pos * invf;
                double rv = (double)ang * 0.15915494309189535; rv -= __builtin_rint(rv); const float fr = (float)rv;
                cs[e] = __builtin_amdgcn_cosf(fr); sn[e] = __builtin_amdgcn_sinf(fr); }
        } else {
#pragma unroll
            for (int e = 0; e < 8; ++e) { cs[e] = 1.f; sn[e] = 0.f; }
        }
        bf16_t* urow = U + (size_t)m * INC;
        u32x4 raws[4];
#pragma unroll
        for (int j = 0; j < 4; ++j) raws[j] = ((const u32x4*)urow)[lane + 64 * j];
#pragma unroll
        for (int j = 0; j < 4; ++j) {
            const u32x4 raw = raws[j];
            float v[8];
#pragma unroll
            for (int e = 0; e < 4; ++e) { v[2 * e] = __uint_as_float(raw[e] << 16); v[2 * e + 1] = __uint_as_float(raw[e] & 0xffff0000u); }
            float ss = 0.f;
#pragma unroll
            for (int e = 0; e < 8; ++e) ss += v[e] * v[e];
            ss += shx(ss, 1, lane); ss += shx(ss, 2, lane); ss += shx(ss, 4, lane); ss += shx(ss, 8, lane);
            const float rstd = 1.0f / sqrtf(ss * (1.0f / 128.0f) + EPS);
            const float* gp = (j < 2 ? qn : kn) + 8 * cw;
            const f32x4 g0 = *(const f32x4*)gp, g1 = *(const f32x4*)(gp + 4);
            float y[8];
#pragma unroll
            for (int e = 0; e < 8; ++e) y[e] = v[e] * rstd * (e < 4 ? g0[e] : g1[e - 4]);
            const float sgn = (cw < 2) ? -1.f : 1.f;
#pragma unroll
            for (int e = 0; e < 8; ++e) { const float yp = shx(y[e], 2, lane); y[e] = y[e] * cs[e] + sgn * yp * sn[e]; }
            if (j < 2) {
#pragma unroll
                for (int e = 0; e < 8; ++e) y[e] *= QSCALE;
            }
            u32x4 w; w.x = cvtpk(y[0], y[1]); w.y = cvtpk(y[2], y[3]); w.z = cvtpk(y[4], y[5]); w.w = cvtpk(y[6], y[7]);
            ((u32x4*)urow)[lane + 64 * j] = w;
        }
    }
}

namespace att {
constexpr int ULD = INC, STAGE = 65536;
constexpr float NEG = -1e30f;
DI int crow(int i, int h) { return (i & 3) + 8 * (i >> 2) + 4 * h; }
DI void glds16(const void* g, LAS unsigned char* l) { __builtin_amdgcn_global_load_lds((const unsigned*)g, (LAS unsigned*)l, 16, 0, 0); }
template <int MODE> DI void load_tile128(const bf16_t* g, LAS unsigned char* dst, int wid, int lane) {
#pragma unroll
    for (int t = 0; t < 2; ++t) { const int ci = wid + 8 * t, R = 4 * ci + (lane >> 4), cp = lane & 15;
        const int c = MODE == 0 ? (cp ^ (R & 15)) : ((((cp >> 2) ^ (R & 3)) << 2) | (cp & 3));
        glds16(g + (size_t)R * ULD + c * 8, dst + ci * 1024); }
}
DI void load_tile256(const bf16_t* g, LAS unsigned char* dst, int wid, int lane) {
#pragma unroll
    for (int t = 0; t < 4; ++t) { const int ci = wid + 8 * t, R = 2 * ci + (lane >> 5), cp = lane & 31;
        const int c = (((cp >> 2) ^ (R & 3)) << 2) | (cp & 3);
        glds16(g + (size_t)R * ULD + c * 8, dst + ci * 1024); }
}
DI s16x4 vtr(const LAS unsigned char* p) { typedef short v4i16_t __attribute__((ext_vector_type(4))); return __builtin_bit_cast(s16x4, __builtin_amdgcn_ds_read_tr16_b64_v4i16((LAS v4i16_t*)p)); }
DI bf16x8 pack8(const f32x16& x, int s) {
    u32x4 p; p.x = cvtpk(x[8 * s], x[8 * s + 1]); p.y = cvtpk(x[8 * s + 2], x[8 * s + 3]); p.z = cvtpk(x[8 * s + 4], x[8 * s + 5]); p.w = cvtpk(x[8 * s + 6], x[8 * s + 7]);
    return __builtin_bit_cast(bf16x8, p);
}
#define MFMA32(a, b, c) __builtin_amdgcn_mfma_f32_32x32x16_bf16((a), (b), (c), 0, 0, 0)
DI void qk_tile(f32x16 (&sT)[2], const LAS unsigned char* kimg, const bf16x8 (&qf)[8], int r, int h) {
    const LAS unsigned char* kp = kimg + r * 256; const int sw = r & 15;
    bf16x8 kf[2][2][2];
#define QK_LOAD(bt) do { _Pragma("unroll") for (int s2 = 0; s2 < 2; ++s2) _Pragma("unroll") for (int kb = 0; kb < 2; ++kb) \
        kf[(bt) & 1][s2][kb] = *(const LAS bf16x8*)(kp + kb * 8192 + (((2 * (2 * (bt) + s2) + h) ^ sw) << 4)); } while (0)
    QK_LOAD(0);
    f32x16 a0 = {}, a1 = {};
#pragma unroll
    for (int bt = 0; bt < 4; ++bt) {
        if (bt + 1 < 4) QK_LOAD(bt + 1);
        __builtin_amdgcn_sched_barrier(0);
#pragma unroll
        for (int s2 = 0; s2 < 2; ++s2) { a0 = MFMA32(kf[bt & 1][s2][0], qf[2 * bt + s2], a0); a1 = MFMA32(kf[bt & 1][s2][1], qf[2 * bt + s2], a1); }
        __builtin_amdgcn_sched_barrier(0);
    }
#undef QK_LOAD
    sT[0] = a0; sT[1] = a1;
}
DI f32x16 qk_half_lq(const LAS unsigned char* kimg32, const LAS unsigned char* qimg, int r, int h) {
    const int sw = r & 15; const LAS unsigned char* kp = kimg32 + r * 256; const LAS unsigned char* qp = qimg + r * 256;
    bf16x8 kf[2][2], qv[2][2];
#define QK_LOAD(bt) do { _Pragma("unroll") for (int s2 = 0; s2 < 2; ++s2) { const int co = (((2 * (2 * (bt) + s2) + h) ^ sw) << 4); qv[(bt) & 1][s2] = *(const LAS bf16x8*)(qp + co); \
        kf[(bt) & 1][s2] = *(const LAS bf16x8*)(kp + co); } } while (0)
    QK_LOAD(0);
    f32x16 a0 = {};
#pragma unroll
    for (int bt = 0; bt < 4; ++bt) {
        if (bt + 1 < 4) QK_LOAD(bt + 1);
        __builtin_amdgcn_sched_barrier(0);
#pragma unroll
        for (int s2 = 0; s2 < 2; ++s2) a0 = MFMA32(kf[bt & 1][s2], qv[bt & 1][s2], a0);
        __builtin_amdgcn_sched_barrier(0);
    }
#undef QK_LOAD
    return a0;
}
template <int RB> DI void pv_half(f32x16 (&o)[4], const f32x16& x, const LAS unsigned char* vimg, int lane, int kb) {
    const int h = lane >> 5, half = (lane >> 4) & 1, q = (lane & 15) >> 2, p = lane & 3;
    const LAS unsigned char* vb = vimg + (32 * kb + 4 * h + q) * RB + 32 * half + 8 * p;
    s16x4 lo[2][4], hi[2][4];
#pragma unroll
    for (int db = 0; db < 4; ++db) { const LAS unsigned char* a = vb + ((db ^ q) << 6); lo[0][db] = vtr(a); hi[0][db] = vtr(a + 8 * RB); }
#pragma unroll
    for (int s = 0; s < 2; ++s) {
        const bf16x8 pf = pack8(x, s);
        if (s == 0) {
#pragma unroll
            for (int db = 0; db < 4; ++db) { const LAS unsigned char* a = vb + ((db ^ q) << 6) + 16 * RB; lo[1][db] = vtr(a); hi[1][db] = vtr(a + 8 * RB); }
        }
        __builtin_amdgcn_sched_barrier(0);
#pragma unroll
        for (int db = 0; db < 4; ++db) { const bf16x8 vf = __builtin_shufflevector(lo[s][db], hi[s][db], 0, 1, 2, 3, 4, 5, 6, 7); o[db] = MFMA32(vf, pf, o[db]); }
        __builtin_amdgcn_sched_barrier(0);
    }
}
template <int RB> DI void pv_tile(f32x16 (&o)[4], const f32x16 (&sT)[2], const LAS unsigned char* vimg, int lane, int db0) {
    const int h = lane >> 5, half = (lane >> 4) & 1, q = (lane & 15) >> 2, p = lane & 3;
    const LAS unsigned char* vb = vimg + (4 * h + q) * RB + 32 * half + 8 * p;
    const LAS unsigned char* va[4];
#pragma unroll
    for (int db = 0; db < 4; ++db) va[db] = vb + (((db0 + db) ^ q) << 6);
    s16x4 lo[2][4], hi[2][4];
#pragma unroll
    for (int db = 0; db < 4; ++db) { lo[0][db] = vtr(va[db]); hi[0][db] = vtr(va[db] + 8 * RB); }
#pragma unroll
    for (int s = 0; s < 4; ++s) {
        const bf16x8 pf = pack8(sT[s >> 1], s & 1);
        if (s + 1 < 4) {
#pragma unroll
            for (int db = 0; db < 4; ++db) { lo[(s + 1) & 1][db] = vtr(va[db] + 16 * (s + 1) * RB); hi[(s + 1) & 1][db] = vtr(va[db] + 16 * (s + 1) * RB + 8 * RB); }
        }
        __builtin_amdgcn_sched_barrier(0);
#pragma unroll
        for (int db = 0; db < 4; ++db) { const bf16x8 vf = __builtin_shufflevector(lo[s & 1][db], hi[s & 1][db], 0, 1, 2, 3, 4, 5, 6, 7); o[db] = MFMA32(vf, pf, o[db]); }
        __builtin_amdgcn_sched_barrier(0);
    }
}

DI f32x16 qk_half(const LAS unsigned char* kimg32, const bf16x8 (&qf)[8], int r, int h) {
    const int sw = r & 15; const LAS unsigned char* kp = kimg32 + r * 256;
    bf16x8 kf[8];
#pragma unroll
    for (int s = 0; s < 8; ++s) kf[s] = *(const LAS bf16x8*)(kp + (((2 * s + h) ^ sw) << 4));
    f32x16 a0 = {};
#pragma unroll
    for (int s = 0; s < 8; ++s) a0 = MFMA32(kf[s], qf[s], a0);
    return a0;
}
DI void diff_unit(int bh, int qb, const bf16_t* __restrict__ U, bf16_t* __restrict__ AO, const float* __restrict__ subln, float lam, LAS unsigned char* lds, int wid, int lane) {
    asm volatile("" : "+v"(lane));
    const int b = bh >> 2, hd = bh & 3, r = lane & 31, h = lane >> 5, pi = wid >> 2, map = (wid >> 1) & 1, dh = wid & 1;
    const int q0w = qb * 64 + 32 * pi;
    const size_t rowbase = (size_t)b * SEQ;
    bf16x8 qf[8];
    { const bf16_t* Qp = U + (rowbase + q0w + r) * ULD + map * 512 + hd * 128 + h * 8;
#pragma unroll
      for (int s = 0; s < 8; ++s) qf[s] = *(const bf16x8*)(Qp + 16 * s); }
    const int NB = 2 * qb + 2, mynb = 2 * qb + pi + 1;
    const bf16_t* Kg1 = U + rowbase * ULD + 1024 + hd * 128;
    const bf16_t* Vg = U + rowbase * ULD + 2048 + hd * 256;
    unsigned offK, offV0, offV1;
    { const int R = 4 * wid + (lane >> 4), cp = lane & 15; offK = (unsigned)(R * ULD + ((cp ^ (R & 15)) << 3)); }
    { const int cp = lane & 31; const int R0 = 2 * wid + (lane >> 5), R1 = R0 + 16;
      offV0 = (unsigned)(R0 * ULD + (((((cp >> 2) ^ (R0 & 3)) << 2) | (cp & 3)) << 3)); offV1 = (unsigned)(R1 * ULD + (((((cp >> 2) ^ (R1 & 3)) << 2) | (cp & 3)) << 3)); }
#define DIFF_PIECE(j, p) do { const int jj_ = (j) < 63 ? (j) : 63; const size_t ko = (size_t)(32 * jj_) * ULD; LAS unsigned char* sp_ = lds + ((j) & 3) * 32768 + wid * 1024; \
        if ((p) == 0) glds16(Kg1 + ko + offK, sp_); else if ((p) == 1) glds16(Kg1 + 512 + ko + offK, sp_ + 8192); else if ((p) == 2) glds16(Vg + ko + offV0, sp_ + 16384); else glds16(Vg + ko + offV1, sp_ + 24576); } while (0)
#define DIFF_ISSUE(j) do { DIFF_PIECE(j, 0); DIFF_PIECE(j, 1); DIFF_PIECE(j, 2); DIFF_PIECE(j, 3); } while (0)
#define DIFF_SYNC() asm volatile("s_waitcnt vmcnt(4) lgkmcnt(0)\n\ts_barrier" ::: "memory")
    f32x16 o[4];
#pragma unroll
    for (int d = 0; d < 4; ++d) o[d] = (f32x16){};
    float mrun = NEG, lrun = 0.f;
    DIFF_ISSUE(0); DIFF_ISSUE(1); DIFF_ISSUE(2);
    asm volatile("s_waitcnt vmcnt(0) lgkmcnt(0)\n\ts_barrier" ::: "memory");
    f32x16 scur = qk_half(lds + map * 8192, qf, r, h);
    const int hq = lane >> 5, half = (lane >> 4) & 1, vq = (lane & 15) >> 2, vp = lane & 3;
    const int voff = 16384 + (4 * hq + vq) * 512 + 32 * half + 8 * vp;
    const int ksw = r & 15;
#define DIFF_MAX() do { float mx = scur[0]; _Pragma("unroll") for (int i = 1; i < 16; ++i) mx = fmaxf(mx, scur[i]); mx = fmaxf(mx, swap32(mx, h)); const float mnew = fmaxf(mrun, mx); \
        if (__any(mnew > mrun)) { const float f = __builtin_amdgcn_exp2f(mrun - mnew); lrun *= f; _Pragma("unroll") for (int d = 0; d < 4; ++d) o[d] = o[d] * f; mrun = mnew; } } while (0)
#define DIFF_VREAD(j) do { const LAS unsigned char* vb = lds + ((j) & 3) * 32768 + voff; _Pragma("unroll") for (int s_ = 0; s_ < 2; ++s_) _Pragma("unroll") for (int db = 0; db < 4; ++db) { \
        const LAS unsigned char* a_ = vb + 16 * s_ * 512 + (((4 * dh + db) ^ vq) << 6); lo[s_][db] = vtr(a_); hi[s_][db] = vtr(a_ + 8 * 512); } } while (0)
#define DIFF_PV() do { _Pragma("unroll") for (int s_ = 0; s_ < 2; ++s_) { const bf16x8 pf = pack8(scur, s_); _Pragma("unroll") for (int db = 0; db < 4; ++db) { \
        const bf16x8 vf = __builtin_shufflevector(lo[s_][db], hi[s_][db], 0, 1, 2, 3, 4, 5, 6, 7); o[db] = MFMA32(vf, pf, o[db]); } } } while (0)
    int j = 0;
    for (; j < mynb - 1; ++j) {
        DIFF_MAX();
        DIFF_SYNC();
        bf16x8 kf[8]; s16x4 lo[2][4], hi[2][4];
        { const LAS unsigned char* kp = lds + ((j + 1) & 3) * 32768 + map * 8192 + r * 256;
#pragma unroll
          for (int s = 0; s < 8; ++s) kf[s] = *(const LAS bf16x8*)(kp + (((2 * s + h) ^ ksw) << 4)); }
        __builtin_amdgcn_sched_barrier(0);
        f32x16 sn = {}; float ps = 0.f;
        const LAS unsigned char* vbj = lds + (j & 3) * 32768 + voff;
#pragma unroll
        for (int s = 0; s < 8; ++s) {
            sn = MFMA32(kf[s], qf[s], sn);
            if (s < 4) {
#pragma unroll
                for (int s_ = 0; s_ < 2; ++s_) { const LAS unsigned char* a_ = vbj + 16 * s_ * 512 + (((4 * dh + s) ^ vq) << 6); lo[s_][s] = vtr(a_); hi[s_][s] = vtr(a_ + 8 * 512); }
            }
            if ((s & 1) == 0) DIFF_PIECE(j + 3, s >> 1);
            const float e0 = __builtin_amdgcn_exp2f(scur[2 * s] - mrun), e1 = __builtin_amdgcn_exp2f(scur[2 * s + 1] - mrun);
            scur[2 * s] = e0; scur[2 * s + 1] = e1; ps += e0 + e1;
            __builtin_amdgcn_sched_barrier(0);
        }
        lrun += ps;
        DIFF_PV();
        scur = sn;
    }
    {
#pragma unroll
        for (int i = 0; i < 16; ++i) if (crow(i, h) > r) scur[i] = NEG;
        DIFF_MAX();
        DIFF_SYNC();
        DIFF_ISSUE(j + 3);
        s16x4 lo[2][4], hi[2][4];
        DIFF_VREAD(j);
        float ps = 0.f;
#pragma unroll
        for (int i = 0; i < 16; ++i) { const float pe = __builtin_amdgcn_exp2f(scur[i] - mrun); scur[i] = pe; ps += pe; }
        lrun += ps;
        DIFF_PV();
        ++j;
    }
    for (; j < NB; ++j) { DIFF_SYNC(); DIFF_ISSUE(j + 3); }
#undef DIFF_MAX
#undef DIFF_VREAD
#undef DIFF_PV
#undef DIFF_SYNC
#undef DIFF_PIECE
#undef DIFF_ISSUE
    block_sync();
    const float ltot = lrun + swap32(lrun, h);
    LAS float* comb = (LAS float*)(lds + (pi * 2 + dh) * 16384) + lane;
    LAS float* ssb = (LAS float*)(lds + 65536);
    if (map == 1) {
        const float sc = lam / ltot;
#pragma unroll
        for (int d = 0; d < 4; ++d)
#pragma unroll
            for (int i = 0; i < 16; ++i) comb[(d * 16 + i) * 64] = o[d][i] * sc;
    }
    block_sync();
    if (map == 0) {
        const float sc = 1.0f / ltot; float ss = 0.f;
#pragma unroll
        for (int d = 0; d < 4; ++d)
#pragma unroll
            for (int i = 0; i < 16; ++i) { const float v = o[d][i] * sc - comb[(d * 16 + i) * 64]; o[d][i] = v; ss += v * v; }
        ss += swap32(ss, h);
        if (h == 0) ssb[(pi * 2 + dh) * 32 + r] = ss;
    }
    block_sync();
    if (map == 0) {
        const float ss = ssb[(pi * 2) * 32 + r] + ssb[(pi * 2 + 1) * 32 + r];
        const float rstd = 0.8f / sqrtf(ss * (1.0f / 256.0f) + EPS);
        bf16_t* orow = AO + (rowbase + q0w + r) * DM + hd * 256 + dh * 128 + 4 * h;
        const float* gp = subln + dh * 128 + 4 * h;
#pragma unroll
        for (int d = 0; d < 4; ++d)
#pragma unroll
            for (int g = 0; g < 4; ++g) { const f32x4 gv = *(const f32x4*)(gp + 32 * d + 8 * g);
                u32x2 w; w.x = cvtpk(o[d][4 * g] * rstd * gv.x, o[d][4 * g + 1] * rstd * gv.y); w.y = cvtpk(o[d][4 * g + 2] * rstd * gv.z, o[d][4 * g + 3] * rstd * gv.w);
                *(u32x2*)(orow + 32 * d + 8 * g) = w; }
    }
    block_sync();
}

template <bool MASKED> DI void sb_weights(f32x16& x, float& base, int kbase  , int qg, int h) {
    float L[16];
#pragma unroll
    for (int i = 0; i < 16; ++i) { const float z = x[i]; const float e = __builtin_amdgcn_exp2f(-fabsf(z));
        float l2 = -(fmaxf(z, 0.f) + __builtin_amdgcn_logf(1.0f + e));
        if (MASKED) { const int kg = kbase + crow(i, h); if (!(kg < qg)) l2 = 0.f; }
        L[i] = l2; if ((i & 7) == 7) __builtin_amdgcn_sched_barrier(0); }
    float T[4], To[4];
#pragma unroll
    for (int g = 0; g < 4; ++g) { L[4 * g + 2] += L[4 * g + 3]; L[4 * g + 1] += L[4 * g + 2]; L[4 * g] += L[4 * g + 1]; T[g] = L[4 * g]; To[g] = swap32(T[g], h); }
    float off[4]; float suf = 0.f;
#pragma unroll
    for (int g = 3; g >= 0; --g) { off[g] = suf + (h == 0 ? To[g] : 0.f); suf += T[g] + To[g]; }
#pragma unroll
    for (int i = 0; i < 16; ++i) { const float c = L[i] + off[i >> 2] + base; float a = __builtin_amdgcn_exp2f(x[i] + c);
        if (MASKED) { const int kg = kbase + crow(i, h); if (!(kg < qg)) a = 0.f; }
        x[i] = a; if ((i & 7) == 7) __builtin_amdgcn_sched_barrier(0); }
    base += suf;
}
constexpr float SB_CUT = 48.0f;
DI void sb_unit(int bh, int qb, const bf16_t* __restrict__ U, bf16_t* __restrict__ AO, LAS unsigned char* lds, int wid, int lane) {
    asm volatile("" : "+v"(lane));
    const int b = bh >> 3, hd = bh & 7, r = lane & 31, h = lane >> 5;
    const int q0w = qb * 256 + 32 * wid;
    const size_t rowbase = (size_t)b * SEQ;
    LAS unsigned char* qimg = lds + (wid < 4 ? 32768 + wid * 8192 : 98304 + (wid - 4) * 8192);
    { const bf16_t* Qp = U + (rowbase + q0w) * ULD + 3072 + hd * 128;
#pragma unroll
      for (int t = 0; t < 8; ++t) { const int Rr = 4 * t + (lane >> 4), cp = lane & 15; glds16(Qp + (size_t)Rr * ULD + ((cp ^ (Rr & 15)) << 3), qimg + t * 1024); } }
    const bf16_t* Kg = U + rowbase * ULD + 4096 + hd * 128;
    const bf16_t* Vg = U + rowbase * ULD + 5120 + hd * 128;
    const int NT = 4 * qb + 4;
    volatile LAS int* flags = (volatile LAS int*)(lds + MISC_OFF + 64);
    f32x16 o[4];
#pragma unroll
    for (int d = 0; d < 4; ++d) o[d] = (f32x16){};
    float R = 0.f;
#define SB_ISSUE(kt, st) do { const size_t ko = (size_t)(64 * (kt)) * ULD; LAS unsigned char* sp = lds + (st) * STAGE; \
        load_tile128<0>(Kg + ko, sp, wid, lane); load_tile128<1>(Vg + ko, sp + 16384, wid, lane); } while (0)
    SB_ISSUE(NT - 1, 0);
    const int qg = q0w + r;
    for (int ti = 0; ti < NT; ++ti) {
        const int kt = NT - 1 - ti;
        block_sync();
        if (ti > 0) { int alld = 1;
#pragma unroll
            for (int w = 0; w < 8; ++w) alld &= flags[((ti - 1) & 1) * 8 + w];
            if (alld) break; }
        if (ti + 1 < NT) SB_ISSUE(kt - 1, (ti + 1) & 1);
        int mydone = 0;
        if (64 * kt < q0w + 31) {
            if (!__all(R < -SB_CUT)) {
                const LAS unsigned char* sp = lds + (ti & 1) * STAGE;
                const bool masked = !(64 * kt + 63 < q0w);
#pragma unroll
                for (int kb = 1; kb >= 0; --kb) {
                    f32x16 x = qk_half_lq(sp + kb * 8192, qimg, r, h);
                    if (masked) sb_weights<true>(x, R, 64 * kt + 32 * kb, qg, h); else sb_weights<false>(x, R, 64 * kt + 32 * kb, qg, h);
                    pv_half<256>(o, x, sp + 16384, lane, kb);
                }
            }
            mydone = __all(R < -SB_CUT) ? 1 : 0;
        }
        if (lane == 0) flags[(ti & 1) * 8 + wid] = mydone;
    }
#undef SB_ISSUE
    bf16_t* orow = AO + (rowbase + q0w + r) * DM + 1024 + hd * 128 + 4 * h;
#pragma unroll
    for (int d = 0; d < 4; ++d)
#pragma unroll
        for (int g = 0; g < 4; ++g) { u32x2 w; w.x = cvtpk(o[d][4 * g], o[d][4 * g + 1]); w.y = cvtpk(o[d][4 * g + 2], o[d][4 * g + 3]); *(u32x2*)(orow + 32 * d + 8 * g) = w; }
    block_sync();
}
}

#define XB_TMO      128
#define XB_XCNT(j)  (256  + 64 * (j))
#define XB_XSUB(j)  (1280 + 64 * (j))
#define XB_XGEN(j)  (2304 + 64 * (j))
#define XB_TOP      3328
#define XB_TOPGEN   3392
#define XCD_BAR_WORDS 3456
#define XB_SPIN_CAP (1u << 18)

__device__ __forceinline__ unsigned xb_ld(unsigned* p)              { return __hip_atomic_load(p, __ATOMIC_RELAXED, __HIP_MEMORY_SCOPE_AGENT); }
__device__ __forceinline__ unsigned xb_add(unsigned* p, unsigned v) { return __hip_atomic_fetch_add(p, v, __ATOMIC_RELAXED, __HIP_MEMORY_SCOPE_AGENT); }
__device__ __forceinline__ unsigned xb_xcc_id() { return (unsigned)__builtin_amdgcn_s_getreg((3 << 11) | 20) & 0xFu; }
#define XB_SPIN(cond, bar) do { unsigned _sp = 0; while (cond) { __builtin_amdgcn_s_sleep(1); \
    if ((++_sp & 255u) == 0u) { if (xb_ld(&(bar)[XB_TMO])) break; if (_sp > XB_SPIN_CAP) { atomicAdd(&(bar)[XB_TMO], 1u); break; } } } } while (0)

struct XcdBarrier {
    unsigned* bar; unsigned x;
    volatile LAS unsigned* st;
};

__device__ __forceinline__ XcdBarrier xcd_barrier_post(unsigned* bar, volatile LAS unsigned* st) {
    XcdBarrier b; b.bar = bar; b.x = xb_xcc_id(); b.st = st;
    if (threadIdx.x == 0) (void)xb_add(&bar[XB_XCNT(b.x)], 1u);
    return b;
}
__device__ __forceinline__ void xcd_barrier_complete(unsigned* bar, unsigned x, unsigned& nloc, unsigned& nx) {
    const unsigned G = gridDim.x * gridDim.y * gridDim.z;
    unsigned sum, cnt, mine, sp = 0u;
    for (;;) {
        sum = 0u; cnt = 0u; mine = 0u;
#pragma unroll
        for (unsigned j = 0; j < 16; ++j) { const unsigned c = xb_ld(&bar[XB_XCNT(j)]); sum += c; cnt += (c > 0u) ? 1u : 0u; mine = (j == x) ? c : mine; }
        if (sum == G) break;
        __builtin_amdgcn_s_sleep(1);
        if ((++sp & 255u) == 0u) { if (xb_ld(&bar[XB_TMO])) break; if (sp > XB_SPIN_CAP) { atomicAdd(&bar[XB_TMO], 1u); break; } }
    }
    nloc = mine > 0u ? mine : 1u; nx = cnt > 0u ? cnt : 1u;
}

__device__ __forceinline__ void xcd_barrier(const XcdBarrier& b) {
    asm volatile("s_waitcnt vmcnt(0)" ::: "memory");
    __syncthreads();
    if (threadIdx.x == 0) {
        unsigned* bar = b.bar;
        __builtin_amdgcn_s_waitcnt(0);
        unsigned nloc = b.st[0], nx = b.st[1];
        if (nloc == 0u) { xcd_barrier_complete(bar, b.x, nloc, nx); b.st[0] = nloc; b.st[1] = nx; }
        const unsigned old = xb_add(&bar[XB_XSUB(b.x)], 1u);
        const unsigned gen = old / nloc;
        if (old + 1u == (gen + 1u) * nloc) {
            __builtin_amdgcn_fence(__ATOMIC_RELEASE, "agent");
            asm volatile("s_waitcnt vmcnt(0)" ::: "memory");
            const unsigned og = xb_add(&bar[XB_TOP], 1u);
            const unsigned tg = og / nx;
            if (og + 1u == (tg + 1u) * nx) xb_add(&bar[XB_TOPGEN], 1u);
            else XB_SPIN(xb_ld(&bar[XB_TOPGEN]) == tg, bar);
            __builtin_amdgcn_fence(__ATOMIC_ACQUIRE, "agent");
            xb_add(&bar[XB_XGEN(b.x)], 1u);
            asm volatile("s_waitcnt vmcnt(0)" ::: "memory");
        } else {
            XB_SPIN(xb_ld(&bar[XB_XGEN(b.x)]) == gen, bar);
            __builtin_amdgcn_fence(__ATOMIC_ACQUIRE, "agent");
            asm volatile("s_waitcnt vmcnt(0)" ::: "memory");
        }
    }
    __syncthreads();
}

struct Args { const float* in[20]; float* out; unsigned char* ws; };
enum { I_X = 0, I_N1, I_G1, I_U1, I_D1, I_NM, I_WIN, I_QN, I_KN, I_LQ1, I_LK1, I_LQ2, I_LK2, I_SUBLN, I_WOUT, I_N2, I_G2, I_U2, I_D2, I_NF };

__global__ void __launch_bounds__(NTHREADS, 2) fwd_megakernel(Args a) {
    extern __shared__ __attribute__((aligned(16))) unsigned char lds_raw[];
    LAS unsigned char* lds = (LAS unsigned char*)lds_raw;
    cg::grid_group grid = cg::this_grid();
    { volatile LAS unsigned* st0 = (volatile LAS unsigned*)(lds + MISC_OFF + 128); if (threadIdx.x == 0) { st0[0] = 0u; st0[1] = 0u; } __syncthreads(); }
    if (blockIdx.x == 0) for (int i = threadIdx.x; i < 16384; i += NTHREADS) ((unsigned*)(a.ws + WS_CTL))[i] = 0u;
#define GRID_BAR() xcd_barrier(xbar)
    const int G = gridDim.x, NGW = G * NWAVES;
    const int wid0 = __builtin_amdgcn_readfirstlane((int)threadIdx.x >> 6);
#define PHASE_IDS int lane = (int)__builtin_amdgcn_mbcnt_hi(~0u, __builtin_amdgcn_mbcnt_lo(~0u, 0u)); asm volatile("" : "+v"(lane)); const int wid = wid0, tid = wid * 64 + lane, gw = blockIdx.x * NWAVES + wid; (void)gw; (void)tid;
    unsigned char* ws = a.ws;
    unsigned* ctl = (unsigned*)(ws + WS_CTL);
    bf16_t* Wgu1 = (bf16_t*)(ws + WS_WGU1); bf16_t* Wd1 = (bf16_t*)(ws + WS_WD1); bf16_t* Win = (bf16_t*)(ws + WS_WIN); bf16_t* Wout = (bf16_t*)(ws + WS_WOUT);
    bf16_t* Wgu2 = (bf16_t*)(ws + WS_WGU2); bf16_t* Wd2 = (bf16_t*)(ws + WS_WD2);
    bf16_t* XN = (bf16_t*)(ws + WS_XN); bf16_t* BIG = (bf16_t*)(ws + WS_BIG);
    bf16_t* X1B = (bf16_t*)a.out; bf16_t* X2B = (bf16_t*)a.out + (size_t)M * DM;
    float* SSP = (float*)(ws + WS_SSP); LAS float* rsl = (LAS float*)(lds + pg8::RS_LDS_OFF);
    float* X = a.out;

    {
        PHASE_IDS
        LAS float* scr = (LAS float*)(lds + wid * 16384);
        constexpr int I_FF = (DM / 64) * (DFF / 32), I_DN = (DFF / 64) * (DM / 32), I_IN = (DM / 64) * (INC / 32), I_OUT = (DM / 64) * (DM / 32);
        constexpr int NITEMS = 4 * I_FF + 2 * I_DN + I_IN + I_OUT;
        for (int it = gw; it < NITEMS; it += NGW) {
            int r = it;
            if (r < I_FF) { transpose_item<false>(a.in[I_G1], DM, DFF, Wgu1, 1, 0, 0, 1.f, nullptr, scr, r, lane); continue; } r -= I_FF;
            if (r < I_FF) { transpose_item<false>(a.in[I_U1], DM, DFF, Wgu1, 2, 0, 0, 1.f, nullptr, scr, r, lane); continue; } r -= I_FF;
            if (r < I_DN) { transpose_item<false>(a.in[I_D1], DFF, DM, Wd1, 0, 0, 0, 1.f, nullptr, scr, r, lane); continue; } r -= I_DN;
            if (r < I_IN) { transpose_item<true>(a.in[I_WIN], DM, INC, Win, 0, 3072, 4096, QSCALE, a.in[I_NM], scr, r, lane); continue; } r -= I_IN;
            if (r < I_OUT) { transpose_item<false>(a.in[I_WOUT], DM, DM, Wout, 0, 0, 0, 1.f, nullptr, scr, r, lane); continue; } r -= I_OUT;
            if (r < I_FF) { transpose_item<true>(a.in[I_G2], DM, DFF, Wgu2, 1, 0, 0, 1.f, a.in[I_N2], scr, r, lane); continue; } r -= I_FF;
            if (r < I_FF) { transpose_item<true>(a.in[I_U2], DM, DFF, Wgu2, 2, 0, 0, 1.f, a.in[I_N2], scr, r, lane); continue; } r -= I_FF;
            transpose_item<false>(a.in[I_D2], DFF, DM, Wd2, 0, 0, 0, 1.f, nullptr, scr, r, lane);
        }
        rms_rows<false>(a.in[I_X], a.in[I_N1], XN, nullptr, gw, NGW, lane);
    }
    grid.sync();
    const XcdBarrier xbar = xcd_barrier_post((unsigned*)(a.ws + WS_CTL) + 4096, (volatile LAS unsigned*)(lds + MISC_OFF + 128));
    { pg8::Gemm g{XN, Wgu1, M, 2 * DFF, DM}; pg8::StaticOrder S; S.init(M, 2 * DFF, G, (int)blockIdx.x); pg8::EpiSwiGLU<false> E{BIG, DFF, rsl};
      pg8::gemm_phase<pg8::EpiSwiGLU<false>, pg8::StaticOrder, true, true>(lds, g, S, E, wid0); }
    GRID_BAR();
    { pg8::Gemm g{BIG, Wd1, M, DM, DFF}; pg8::StaticOrder S; S.init(M, DM, G, (int)blockIdx.x); typedef pg8::EpiResidB<false, 1, WS_SSP> Epi2; Epi2 E{a.in[I_X], X1B, DM, ws};
      pg8::gemm_phase<Epi2, pg8::StaticOrder, true, true>(lds, g, S, E, wid0); }
    GRID_BAR();
    { pg8::Gemm g{X1B, Win, M, INC, DM}; pg8::StaticOrder S; S.init(M, INC, G, (int)blockIdx.x); pg8::EpiQKV E{BIG, rsl, a.in[I_QN], a.in[I_KN]};
      { PHASE_IDS pg8::Unit u0; if (S.next(0, u0)) build_rs(rsl, SSP, u0.pm & ~7, wid, lane); else block_sync(); }
      pg8::gemm_phase<pg8::EpiQKV, pg8::StaticOrder, true, true>(lds, g, S, E, wid0); }
    GRID_BAR();
    {
        PHASE_IDS
        float lam;
        { const float p1 = a.in[I_LQ1][lane] * a.in[I_LK1][lane] + a.in[I_LQ1][lane + 64] * a.in[I_LK1][lane + 64];
          const float p2 = a.in[I_LQ2][lane] * a.in[I_LK2][lane] + a.in[I_LQ2][lane + 64] * a.in[I_LK2][lane + 64];
          lam = expf(wave_sum(p1, lane)) - expf(wave_sum(p2, lane)) + 0.2f; }
        volatile LAS int* sh = (volatile LAS int*)(lds + MISC_OFF);
        const int myx = (int)(__builtin_amdgcn_s_getreg((3 << 11) | 20) & 7u);
        for (int k = 0; k < 8; ++k) {
            const int qx = (myx + k) & 7; unsigned* cnt = ctl + 64 * (1 + qx);
            if (k == 1) { if (tid < 8) sh[8 + tid] = (int)__hip_atomic_load(ctl + 64 * (1 + tid), __ATOMIC_RELAXED, __HIP_MEMORY_SCOPE_AGENT); block_sync(); }
            if (k > 0 && sh[8 + qx] >= 128) continue;
            for (;;) {
                if (tid == 0) sh[0] = (int)atomicAdd(cnt, 1u);
                block_sync();
                const int idx = sh[0];
                block_sync();
                if (idx >= 128) break;
#ifndef NO_DIFF
                if (idx < 64) { const int sl = idx & 31, dbh = qx * 4 + 2 * (idx >> 5) + (sl >> 4), qi = sl & 15;
                    for (int rep = 0; rep < 2; ++rep) att::diff_unit(dbh, rep ? 31 - qi : qi, BIG, XN, a.in[I_SUBLN], lam, lds, wid, lane); }
#endif
#ifndef NO_SB
                if (idx >= 64) att::sb_unit(qx * 8 + ((idx - 64) >> 3), 7 - ((idx - 64) & 7), BIG, XN, lds, wid, lane);
#endif
            }
        }
    }
    GRID_BAR();
    { pg8::Gemm g{XN, Wout, M, DM, DM}; pg8::StaticOrder S; S.init(M, DM, G, (int)blockIdx.x); typedef pg8::EpiResidB<true, 2, WS_SSP + 2 * MiB> Epi4; Epi4 E{X1B, X2B, DM, ws};
      pg8::gemm_phase<Epi4, pg8::StaticOrder, true, true>(lds, g, S, E, wid0); }
    GRID_BAR();
    { pg8::Gemm g{X2B, Wgu2, M, 2 * DFF, DM}; pg8::StaticOrder S; S.init(M, 2 * DFF, G, (int)blockIdx.x); pg8::EpiSwiGLU<true> E{BIG, DFF, rsl};
      { PHASE_IDS pg8::Unit u0; if (S.next(0, u0)) build_rs(rsl, SSP + (size_t)M * 32, u0.pm & ~7, wid, lane); else block_sync(); }
      pg8::gemm_phase<pg8::EpiSwiGLU<true>, pg8::StaticOrder, true, true>(lds, g, S, E, wid0); }
    GRID_BAR();
    { pg8::Gemm g{BIG, Wd2, M, DM, DFF}; pg8::StaticOrder S; S.init(M, DM, G, (int)blockIdx.x); typedef pg8::EpiResidB<true, 1, WS_SSP + 4 * MiB> Epi6; Epi6 E{X2B, XN, DM, ws};
      pg8::gemm_phase<Epi6, pg8::StaticOrder, true, true>(lds, g, S, E, wid0); }
    GRID_BAR();
    { PHASE_IDS final_rows(X, XN, SSP + (size_t)M * 64, a.in[I_NF], gw, NGW, lane); }
}

extern "C" void kernel_launch(void* const* d_in, const int* in_sizes, int n_in, void* d_out, int out_size, void* d_ws, size_t ws_size, hipStream_t stream) {
    static int grid = 0;
    if (grid == 0) {
        if (n_in != 20 || out_size != M * DM || ws_size < WS_END) { fprintf(stderr, "kernel_launch: unexpected problem (n_in %d out %d ws %zu)\n", n_in, out_size, ws_size); grid = -1; return; }
        int dev = 0, cus = 0, per_cu = 0;
        (void)hipGetDevice(&dev); (void)hipDeviceGetAttribute(&cus, hipDeviceAttributeMultiprocessorCount, dev);
        (void)hipFuncSetAttribute((const void*)fwd_megakernel, hipFuncAttributeMaxDynamicSharedMemorySize, LDS_BYTES);
        (void)hipOccupancyMaxActiveBlocksPerMultiprocessor(&per_cu, (const void*)fwd_megakernel, NTHREADS, LDS_BYTES);
        if (per_cu < 1) { fprintf(stderr, "kernel_launch: occupancy query says %d blocks per CU\n", per_cu); per_cu = 1; }
        grid = cus * 1;
        (void)hipGetLastError();
    }
    if (grid < 0) return;
    Args a{};
    for (int i = 0; i < 20; ++i) a.in[i] = (const float*)d_in[i];
    a.out = (float*)d_out; a.ws = (unsigned char*)d_ws;
    void* args[] = {&a};
    hipError_t e = hipLaunchCooperativeKernel((const void*)fwd_megakernel, dim3(grid), dim3(NTHREADS), args, LDS_BYTES, stream);
    if (e != hipSuccess) fprintf(stderr, "cooperative launch failed: %s (grid %d)\n", hipGetErrorString(e), grid);
}
```

```cpp
#include <hip/hip_cooperative_groups.h>
#include <hip/hip_runtime.h>
#include <cstdio>
#include <cstdint>
namespace pg8 {
#define PG8_LAS __attribute__((address_space(3)))
typedef unsigned short bf16_t;
typedef short bf16x8 __attribute__((ext_vector_type(8)));
typedef float f32x4 __attribute__((ext_vector_type(4)));
typedef unsigned u32x4 __attribute__((ext_vector_type(4)));
constexpr int BM = 256, BK = 64, HALF = 128, HTB = HALF * BK * 2  , STAGE_BYTES = 8 * HTB, NXCD = 8, WGM = 8;

__host__ __device__ __forceinline__ int lds_byte(int r, int c) { const int st = (r >> 4) * 2 + (c >> 5), rr = r & 15, cc = c & 31, ob = rr * 64 + cc * 2; return st * 1024 + (ob ^ (((ob >> 9) & 1) << 5)); }
__host__ __device__ __forceinline__ void stage_rc(int b, int& R, int& C) { const int st = b / 1024, sb = b % 1024, swz = sb ^ (((sb >> 9) & 1) << 5); R = (st >> 1) * 16 + swz / 64; C = (st & 1) * 32 + (swz % 64) / 2; }
__host__ __device__ __forceinline__ int perm32(int rho) { const int n = rho >> 4, i = rho & 15; return 8 * (i >> 2) + 4 * n + (i & 3); }

struct Unit { int pm, pn; };
struct Gemm { const bf16_t* A; const bf16_t* Bt; int M, N, K; };

struct StaticOrder {
    int nM, nN, nwg, G, c;
    __host__ __device__ void init(int M, int N, int G_, int c_) { nM = M / BM; nN = N / BM; nwg = nM * nN; G = G_; c = c_; }
    __host__ __device__ bool next(int i, Unit& u) const {
        const long L = (long)i * G + c; if (L >= nwg) return false;
        int wgid = (int)L; { const int q = nwg / NXCD, r = nwg % NXCD, xcd = wgid % NXCD, off = wgid / NXCD; wgid = (xcd < r ? xcd * (q + 1) : r * (q + 1) + (xcd - r) * q) + off; }
        const int nig = WGM * nN, gid = wgid / nig, fm = gid * WGM, gsz = (nM - fm) < WGM ? (nM - fm) : WGM;
        u.pm = fm + ((wgid % nig) % gsz); u.pn = (wgid % nig) / gsz; return true;
    }
    __device__ __forceinline__ void a_ready(const Unit&) const {}
    __device__ __forceinline__ void done(const Unit&) const {}
};

__device__ __forceinline__ unsigned cvt_pk_bf16(float lo, float hi) { unsigned r; asm volatile("v_cvt_pk_bf16_f32 %0, %1, %2" : "=v"(r) : "v"(lo), "v"(hi)); return r; }
typedef float f32x2 __attribute__((ext_vector_type(2)));
__device__ __forceinline__ f32x2 gelu_pk(f32x2 v) {
    const f32x2 av = __builtin_elementwise_abs(v), d = av * 0.2316418882f + 1.0f;
    f32x2 t; t.x = __builtin_amdgcn_rcpf(d.x); t.y = __builtin_amdgcn_rcpf(d.y);
    f32x2 q = t * 0.5307027145f + (-0.7265760135f); q = q * t + 0.7107068705f; q = q * t + (-0.142248368f); q = q * t + 0.127414796f; q = q * t;
    const f32x2 s = (v * v) * (-0.72134752044f);
    f32x2 e; e.x = __builtin_amdgcn_exp2f(s.x); e.y = __builtin_amdgcn_exp2f(s.y);
    const f32x2 m = v * (q * e), r = v - m;
    f32x2 o; o.x = v.x < 0.f ? m.x : r.x; o.y = v.y < 0.f ? m.y : r.y; return o;
}

template <int ACT  > struct EpiBf16 {
    static constexpr bool PERM = true, AFTER_DRAIN = false; static_assert(ACT == 0 || ACT == 1, "EpiBf16: ACT is 0 (none) or 1 (gelu_pk)");
    bf16_t* O; int ldc; const float* bias; int split_cols; size_t split_stride; float scale0;
    __device__ __forceinline__ void operator()(const f32x4 (&acc)[2][2][4][2], const Unit& u, int wr, int wc, int fr, int fq) const {
        const int row0 = u.pm * BM + wr * 64 + fr; int colt = u.pn * BM; bf16_t* base = O;
        float sc = 1.f; if (split_cols) { const int t = colt / split_cols; base += (size_t)t * split_stride; colt -= t * split_cols; if (t == 0) sc = scale0; }
        const int col0 = colt + wc * 32 + 8 * fq, bcol0 = u.pn * BM + wc * 32 + 8 * fq;
        f32x4 bv[2][2];
#pragma unroll
        for (int bj = 0; bj < 2; ++bj)
#pragma unroll
            for (int n = 0; n < 2; ++n) bv[bj][n] = bias ? *(const f32x4*)(bias + bcol0 + bj * HALF + 4 * n) : (f32x4){0.f, 0.f, 0.f, 0.f};
#pragma unroll
        for (int ai = 0; ai < 2; ++ai)
#pragma unroll
            for (int m = 0; m < 4; ++m) { bf16_t* rowp = base + (size_t)(row0 + ai * HALF + m * 16) * ldc + col0;
#pragma unroll
                for (int bj = 0; bj < 2; ++bj) { f32x4 v0 = acc[ai][bj][m][0] + bv[bj][0], v1 = acc[ai][bj][m][1] + bv[bj][1];
                    if (ACT == 1) { f32x2 a = gelu_pk((f32x2){v0[0], v0[1]}), b = gelu_pk((f32x2){v0[2], v0[3]}), c = gelu_pk((f32x2){v1[0], v1[1]}), d = gelu_pk((f32x2){v1[2], v1[3]});
                        v0 = (f32x4){a.x, a.y, b.x, b.y}; v1 = (f32x4){c.x, c.y, d.x, d.y}; }
                    v0 = v0 * sc; v1 = v1 * sc; u32x4 w; w.x = cvt_pk_bf16(v0[0], v0[1]); w.y = cvt_pk_bf16(v0[2], v0[3]); w.z = cvt_pk_bf16(v1[0], v1[1]); w.w = cvt_pk_bf16(v1[2], v1[3]);
                    *(u32x4*)(rowp + bj * HALF) = w; } }
    }
};

template <class Epi, class Sched, bool ALIGN_EPI = false, bool SP2 = false>
__device__ __forceinline__ void gemm_phase(PG8_LAS unsigned char* lds, const Gemm g, const Sched S, const Epi E, int wid0) {
    int tid_ = wid0 * 64 + (int)__builtin_amdgcn_mbcnt_hi(~0u, __builtin_amdgcn_mbcnt_lo(~0u, 0u)); asm volatile("" : "+v"(tid_));
    const int tid = tid_, wid = __builtin_amdgcn_readfirstlane(tid >> 6), lane = tid & 63, wr = wid >> 2, wc = wid & 3, fr = lane & 15, fq = lane >> 4;
    const int K = g.K, nt = K / BK;
    unsigned voffA[2], voffB[2];
#pragma unroll
    for (int i = 0; i < 2; ++i) { int R, C; stage_rc(tid * 16 + i * 8192, R, C); const int Rb = Epi::PERM ? ((R & ~31) + perm32(R & 31)) : R;
        voffA[i] = (unsigned)(R * K + C) * 2u; voffB[i] = (unsigned)(Rb * K + C) * 2u; }
    const size_t kstep = (size_t)(BK * 2);
    const size_t hstep = (size_t)HALF * K * 2;
    const size_t tstep = 2 * hstep;
    const unsigned ldsw = (unsigned)wid * 1024u;
    const int aoff = lds_byte(wr * 64 + fr, fq * 8), boff = lds_byte(wc * 32 + fr, fq * 8);
#define PG8_SA(b, h) (((b) * 2 + (h)) * HTB)
#define PG8_SB(b, h) ((4 + (b) * 2 + (h)) * HTB)
#define PG8_STAGE(bufoff, gbase, voff) do { _Pragma("unroll") for (int _i = 0; _i < 2; ++_i) \
        __builtin_amdgcn_global_load_lds((const unsigned*)((const char*)(gbase) + (voff)[_i]), (PG8_LAS unsigned*)(lds + (bufoff) + ldsw + _i * 8192), 16, 0, 0); } while (0)
#define PG8_LDA(dst, b, h) do { _Pragma("unroll") for (int m = 0; m < 4; ++m) _Pragma("unroll") for (int k = 0; k < 2; ++k) dst[m][k] = *(const PG8_LAS bf16x8*)(lds + PG8_SA(b, h) + aoff + m * 2048 + k * 1024); } while (0)
#define PG8_LDB(dst, b, h) do { _Pragma("unroll") for (int n = 0; n < 2; ++n) _Pragma("unroll") for (int k = 0; k < 2; ++k) dst[n][k] = *(const PG8_LAS bf16x8*)(lds + PG8_SB(b, h) + boff + n * 2048 + k * 1024); } while (0)
#define PG8_MMA(ai, bj, At, Bt) do { __builtin_amdgcn_s_setprio(1); _Pragma("unroll") for (int m = 0; m < 4; ++m) _Pragma("unroll") for (int n = 0; n < 2; ++n) _Pragma("unroll") for (int k = 0; k < 2; ++k) \
        acc[ai][bj][m][n] = __builtin_amdgcn_mfma_f32_16x16x32_bf16(Bt[n][k], At[m][k], acc[ai][bj][m][n], 0, 0, 0); __builtin_amdgcn_s_setprio(0); } while (0)
#define PG8_WAIT_V(n) asm volatile("s_waitcnt vmcnt(" #n ")" ::: "memory")
#define PG8_WAIT_L(n) asm volatile("s_waitcnt lgkmcnt(" #n ")" ::: "memory")
#define PG8_BAR __builtin_amdgcn_s_barrier()
#define PG8_SCHED __builtin_amdgcn_sched_barrier(0)
    Unit cur, nxt; int ui = 0;
    if (!S.next(0, cur)) return;
    f32x4 acc[2][2][4][2];
#pragma unroll
    for (int a = 0; a < 2; ++a)
#pragma unroll
        for (int b = 0; b < 2; ++b)
#pragma unroll
            for (int m = 0; m < 4; ++m)
#pragma unroll
                for (int n = 0; n < 2; ++n) acc[a][b][m][n] = (f32x4){0.f, 0.f, 0.f, 0.f};
    bf16x8 At[4][2], B0[2][2], B1[2][2];
    const char* cA = (const char*)g.A + (size_t)cur.pm * tstep; const char* cB = (const char*)g.Bt + (size_t)cur.pn * tstep;
    S.a_ready(cur);
    if constexpr (SP2) {
        PG8_STAGE(PG8_SB(0, 0), cB, voffB); PG8_STAGE(PG8_SB(0, 1), cB + hstep, voffB); PG8_STAGE(PG8_SA(0, 0), cA, voffA); PG8_STAGE(PG8_SA(0, 1), cA + hstep, voffA);
        if (wr == 1) PG8_BAR;
        PG8_WAIT_V(2); PG8_BAR;
        PG8_STAGE(PG8_SB(1, 0), cB + kstep, voffB); PG8_STAGE(PG8_SA(1, 0), cA + kstep, voffA); PG8_STAGE(PG8_SB(1, 1), cB + hstep + kstep, voffB);
        PG8_WAIT_V(6); PG8_BAR;
    } else {
        PG8_STAGE(PG8_SB(0, 0), cB, voffB); PG8_STAGE(PG8_SA(0, 0), cA, voffA); PG8_STAGE(PG8_SB(0, 1), cB + hstep, voffB); PG8_STAGE(PG8_SA(0, 1), cA + hstep, voffA);
        if (wr == 1) PG8_BAR;
        PG8_WAIT_V(4); PG8_BAR;
        PG8_STAGE(PG8_SB(1, 0), cB + kstep, voffB); PG8_STAGE(PG8_SA(1, 0), cA + kstep, voffA); PG8_STAGE(PG8_SB(1, 1), cB + hstep + kstep, voffB);
        PG8_WAIT_V(6); PG8_BAR;
    }
    for (;;) {
        const bool has_next = S.next(ui + 1, nxt);
        const char* nA = has_next ? (const char*)g.A + (size_t)nxt.pm * tstep : cA; const char* nB = has_next ? (const char*)g.Bt + (size_t)nxt.pn * tstep : cB;
        for (int t = 0; t < nt; t += 2) {
            const bool last = (t == nt - 2);
            const char* a1 = cA + (size_t)(t + 1) * kstep;
            const char* a2 = last ? nA : cA + (size_t)(t + 2) * kstep; const char* b2 = last ? nB : cB + (size_t)(t + 2) * kstep;
            const char* a3 = a2 + kstep; const char* b3 = b2 + kstep;
            if (last && has_next) S.a_ready(nxt);
            if constexpr (SP2) {
            PG8_LDB(B0, 0, 0); PG8_LDB(B1, 0, 1); PG8_SCHED; PG8_LDA(At, 0, 0); PG8_STAGE(PG8_SA(1, 1), a1 + hstep, voffA);
            PG8_WAIT_V(8); PG8_WAIT_L(0); PG8_BAR; PG8_MMA(0, 0, At, B0); PG8_MMA(0, 1, At, B1); PG8_BAR; PG8_SCHED;
            PG8_LDA(At, 0, 1); PG8_STAGE(PG8_SB(0, 0), b2, voffB); PG8_STAGE(PG8_SB(0, 1), b2 + hstep, voffB); PG8_STAGE(PG8_SA(0, 0), a2, voffA);
            PG8_WAIT_V(8); PG8_WAIT_L(0); PG8_BAR; PG8_MMA(1, 0, At, B0); PG8_MMA(1, 1, At, B1); PG8_BAR; PG8_SCHED;
            PG8_LDB(B0, 1, 0); PG8_LDB(B1, 1, 1); PG8_SCHED; PG8_LDA(At, 1, 0); PG8_STAGE(PG8_SA(0, 1), a2 + hstep, voffA);
            PG8_WAIT_V(8); PG8_WAIT_L(0); PG8_BAR; PG8_MMA(0, 0, At, B0); PG8_MMA(0, 1, At, B1); PG8_BAR; PG8_SCHED;
            PG8_LDA(At, 1, 1); PG8_STAGE(PG8_SB(1, 0), b3, voffB); PG8_STAGE(PG8_SB(1, 1), b3 + hstep, voffB); PG8_STAGE(PG8_SA(1, 0), a3, voffA);
            PG8_WAIT_V(8); PG8_WAIT_L(0); PG8_BAR; PG8_MMA(1, 0, At, B0); PG8_MMA(1, 1, At, B1); PG8_BAR; PG8_SCHED;
            } else {
            PG8_LDB(B0, 0, 0); PG8_SCHED; PG8_LDA(At, 0, 0); PG8_STAGE(PG8_SA(1, 1), a1 + hstep, voffA);
            PG8_WAIT_L(8); PG8_BAR; PG8_WAIT_L(0); PG8_MMA(0, 0, At, B0); PG8_BAR; PG8_SCHED;
            PG8_LDB(B1, 0, 1); PG8_STAGE(PG8_SB(0, 0), b2, voffB);
            PG8_BAR; PG8_WAIT_L(0); PG8_MMA(0, 1, At, B1); PG8_BAR;
            PG8_LDA(At, 0, 1); PG8_STAGE(PG8_SA(0, 0), a2, voffA);
            PG8_BAR; PG8_WAIT_L(0); PG8_MMA(1, 0, At, B0); PG8_BAR; PG8_SCHED;
            PG8_STAGE(PG8_SB(0, 1), b2 + hstep, voffB);
            PG8_WAIT_V(6); PG8_BAR; PG8_MMA(1, 1, At, B1); PG8_BAR;
            PG8_LDB(B0, 1, 0); PG8_SCHED; PG8_LDA(At, 1, 0); PG8_STAGE(PG8_SA(0, 1), a2 + hstep, voffA);
            PG8_WAIT_L(8); PG8_BAR; PG8_WAIT_L(0); PG8_MMA(0, 0, At, B0); PG8_BAR; PG8_SCHED;
            PG8_LDB(B1, 1, 1); PG8_STAGE(PG8_SB(1, 0), b3, voffB);
            PG8_BAR; PG8_WAIT_L(0); PG8_MMA(0, 1, At, B1); PG8_BAR;
            PG8_LDA(At, 1, 1); PG8_STAGE(PG8_SA(1, 0), a3, voffA);
            PG8_BAR; PG8_WAIT_L(0); PG8_MMA(1, 0, At, B0); PG8_BAR; PG8_SCHED;
            PG8_STAGE(PG8_SB(1, 1), b3 + hstep, voffB);
            PG8_WAIT_V(6); PG8_BAR; PG8_MMA(1, 1, At, B1); PG8_BAR;
            }
        }
        if constexpr (ALIGN_EPI) { if (wr == 0) PG8_BAR; }
        if constexpr (!Epi::AFTER_DRAIN) { E(acc, cur, wr, wc, fr, fq); S.done(cur); }
        if (!has_next) break;
#pragma unroll
        for (int a = 0; a < 2; ++a)
#pragma unroll
            for (int b = 0; b < 2; ++b)
#pragma unroll
                for (int m = 0; m < 4; ++m)
#pragma unroll
                    for (int n = 0; n < 2; ++n) acc[a][b][m][n] = (f32x4){0.f, 0.f, 0.f, 0.f};
        cur = nxt; cA = nA; cB = nB; ++ui;
        if constexpr (ALIGN_EPI) { if (wr == 1) PG8_BAR; }
    }
    PG8_WAIT_V(0);
    if constexpr (!ALIGN_EPI) { if (wr == 0) PG8_BAR; }
    PG8_BAR;
    if constexpr (Epi::AFTER_DRAIN) { E.fused(acc, cur, wr, wc, fr, fq, lds, wid, lane); S.done(cur); }
#undef PG8_SA
#undef PG8_SB
#undef PG8_STAGE
#undef PG8_LDA
#undef PG8_LDB
#undef PG8_MMA
#undef PG8_WAIT_V
#undef PG8_WAIT_L
#undef PG8_BAR
#undef PG8_SCHED
}
}
namespace pg8 {
constexpr int RS_LDS_OFF = 131072 + 1024;
__device__ __forceinline__ float bflo(unsigned w) { return __uint_as_float(w << 16); }
__device__ __forceinline__ float bfhi(unsigned w) { return __uint_as_float(w & 0xffff0000u); }
template <bool HAS_RS> struct EpiSwiGLU {
    static constexpr bool PERM = true, AFTER_DRAIN = false;
    bf16_t* O; int ldc; PG8_LAS const float* rsl;
    __device__ __forceinline__ void operator()(const f32x4 (&acc)[2][2][4][2], const Unit& u, int wr, int wc, int fr, int fq) const {
        const int row0 = u.pm * BM + wr * 64 + fr; const int col0 = u.pn * HALF + wc * 32 + 8 * fq;
        float rsv[2][4];
#pragma unroll
        for (int ai = 0; ai < 2; ++ai)
#pragma unroll
            for (int m = 0; m < 4; ++m) rsv[ai][m] = HAS_RS ? rsl[(u.pm & 7) * 256 + wr * 64 + ai * HALF + m * 16 + fr] : 1.0f;
#pragma unroll
        for (int ai = 0; ai < 2; ++ai)
#pragma unroll
            for (int m = 0; m < 4; ++m) { bf16_t* rowp = O + (size_t)(row0 + ai * HALF + m * 16) * ldc + col0; const float rs = rsv[ai][m];
                float hv[8];
#pragma unroll
                for (int n = 0; n < 2; ++n)
#pragma unroll
                    for (int e = 0; e < 4; ++e) { const float g = acc[ai][0][m][n][e] * rs, up = acc[ai][1][m][n][e] * rs;
                        const float ex = __builtin_amdgcn_exp2f(-g * 1.4426950408889634f);
                        hv[n * 4 + e] = g * __builtin_amdgcn_rcpf(1.0f + ex) * up; }
                u32x4 w; w.x = cvt_pk_bf16(hv[0], hv[1]); w.y = cvt_pk_bf16(hv[2], hv[3]); w.z = cvt_pk_bf16(hv[4], hv[5]); w.w = cvt_pk_bf16(hv[6], hv[7]);
                *(u32x4*)rowp = w; }
    }
};
struct EpiBf16Rs {
    static constexpr bool PERM = true, AFTER_DRAIN = false;
    bf16_t* O; int ldc; PG8_LAS const float* rsl;
    __device__ __forceinline__ void operator()(const f32x4 (&acc)[2][2][4][2], const Unit& u, int wr, int wc, int fr, int fq) const {
        const int row0 = u.pm * BM + wr * 64 + fr; const int col0 = u.pn * BM + wc * 32 + 8 * fq;
        float rsv[2][4];
#pragma unroll
        for (int ai = 0; ai < 2; ++ai)
#pragma unroll
            for (int m = 0; m < 4; ++m) rsv[ai][m] = rsl[(u.pm & 7) * 256 + wr * 64 + ai * HALF + m * 16 + fr];
#pragma unroll
        for (int ai = 0; ai < 2; ++ai)
#pragma unroll
            for (int m = 0; m < 4; ++m) { bf16_t* rowp = O + (size_t)(row0 + ai * HALF + m * 16) * ldc + col0; const float rs = rsv[ai][m];
#pragma unroll
                for (int bj = 0; bj < 2; ++bj) { const f32x4 v0 = acc[ai][bj][m][0] * rs, v1 = acc[ai][bj][m][1] * rs;
                    u32x4 w; w.x = cvt_pk_bf16(v0[0], v0[1]); w.y = cvt_pk_bf16(v0[2], v0[3]); w.z = cvt_pk_bf16(v1[0], v1[1]); w.w = cvt_pk_bf16(v1[2], v1[3]);
                    *(u32x4*)(rowp + bj * HALF) = w; } }
    }
};
struct EpiQKV {
    static constexpr bool PERM = true, AFTER_DRAIN = false;
    bf16_t* O; PG8_LAS float* rsl; const float* qn; const float* kn;
    __device__ __forceinline__ void operator()(const f32x4 (&acc)[2][2][4][2], const Unit& u, int wr, int wc, int fr, int fq) const {
        constexpr int ldc = 6144; constexpr float QS = 0.08838834764831845f * 1.4426950408889634f;
        const int rl0 = wr * 64 + fr, row0 = u.pm * BM + rl0, col0 = u.pn * BM + wc * 32 + 8 * fq, lane = fr + 16 * fq;
        float rsv[2][4];
#pragma unroll
        for (int ai = 0; ai < 2; ++ai)
#pragma unroll
            for (int m = 0; m < 4; ++m) rsv[ai][m] = rsl[(u.pm & 7) * 256 + rl0 + ai * HALF + m * 16];
        if (u.pn >= 8) {
#pragma unroll
            for (int ai = 0; ai < 2; ++ai)
#pragma unroll
                for (int m = 0; m < 4; ++m) { bf16_t* rowp = O + (size_t)(row0 + ai * HALF + m * 16) * ldc + col0; const float rs = rsv[ai][m];
#pragma unroll
                    for (int bj = 0; bj < 2; ++bj) { const f32x4 v0 = acc[ai][bj][m][0] * rs, v1 = acc[ai][bj][m][1] * rs;
                        u32x4 w; w.x = cvt_pk_bf16(v0[0], v0[1]); w.y = cvt_pk_bf16(v0[2], v0[3]); w.z = cvt_pk_bf16(v1[0], v1[1]); w.w = cvt_pk_bf16(v1[2], v1[3]);
                        *(u32x4*)(rowp + bj * HALF) = w; } }
            return;
        }
        PG8_LAS float* xs = rsl + 2048;
#pragma unroll
        for (int ai = 0; ai < 2; ++ai)
#pragma unroll
            for (int m = 0; m < 4; ++m) { const float rs = rsv[ai][m];
#pragma unroll
                for (int bj = 0; bj < 2; ++bj) { const f32x4 v0 = acc[ai][bj][m][0] * rs, v1 = acc[ai][bj][m][1] * rs;
                    float sq = ((v0[0] * v0[0] + v0[1] * v0[1]) + (v0[2] * v0[2] + v0[3] * v0[3])) + ((v1[0] * v1[0] + v1[1] * v1[1]) + (v1[2] * v1[2] + v1[3] * v1[3]));
                    sq += __int_as_float(__builtin_amdgcn_ds_bpermute((lane ^ 16) << 2, __float_as_int(sq))); sq += __int_as_float(__builtin_amdgcn_ds_bpermute((lane ^ 32) << 2, __float_as_int(sq)));
                    if (fq == 0) xs[((rl0 + ai * HALF + m * 16) * 2 + bj) * 4 + wc] = sq; } }
        asm volatile("s_waitcnt lgkmcnt(0)" ::: "memory"); __builtin_amdgcn_s_barrier(); asm volatile("" ::: "memory");
        const bool isq = u.pn < 4;
        const float* gp = (isq ? qn : kn) + wc * 32 + 8 * fq;
        const f32x4 g0 = *(const f32x4*)gp, g1 = *(const f32x4*)(gp + 4);
        const float qs = isq ? QS : 1.0f, sgn = (fq < 2) ? -1.0f : 1.0f;
        float invf[8];
#pragma unroll
        for (int e = 0; e < 8; ++e) invf[e] = __builtin_amdgcn_exp2f(-(float)(8 * (fq & 1) + e) * (18.931568569324174f / 16.0f));
#pragma unroll
        for (int ai = 0; ai < 2; ++ai)
#pragma unroll
            for (int m = 0; m < 4; ++m) { const int rl = rl0 + ai * HALF + m * 16, row = u.pm * BM + rl; const float rs = rsv[ai][m];
                float cs[8], sn[8];
                if (wc == 0) { const float pos = (float)(row & 2047);
#pragma unroll
                    for (int e = 0; e < 8; ++e) { const float ang = pos * invf[e]; const float nr = __builtin_rintf(ang * 0.15915494309189535f);
                        float rr_ = __builtin_fmaf(-nr, 6.28318548202514648f, ang); rr_ = __builtin_fmaf(-nr, -1.74845553146951715e-7f, rr_); const float fr_ = rr_ * 0.15915494309189535f;
                        cs[e] = __builtin_amdgcn_cosf(fr_); sn[e] = __builtin_amdgcn_sinf(fr_); } }
#pragma unroll
                for (int bj = 0; bj < 2; ++bj) { const f32x4 pp = *(const PG8_LAS f32x4*)(xs + (rl * 2 + bj) * 4);
                    const float k = rs * qs / sqrtf(((pp[0] + pp[1]) + (pp[2] + pp[3])) * (1.0f / 128.0f) + 1e-5f);
                    float y[8];
#pragma unroll
                    for (int e = 0; e < 8; ++e) y[e] = acc[ai][bj][m][e >> 2][e & 3] * (e < 4 ? g0[e] : g1[e - 4]);
                    if (wc == 0) {
#pragma unroll
                        for (int e = 0; e < 8; ++e) { auto rr = __builtin_amdgcn_permlane32_swap(__float_as_uint(y[e]), __float_as_uint(y[e]), false, false);
                            const float yp = __uint_as_float((fq >> 1) ? rr[0] : rr[1]); y[e] = y[e] * cs[e] + sgn * yp * sn[e]; } }
                    u32x4 w; w.x = cvt_pk_bf16(y[0] * k, y[1] * k); w.y = cvt_pk_bf16(y[2] * k, y[3] * k); w.z = cvt_pk_bf16(y[4] * k, y[5] * k); w.w = cvt_pk_bf16(y[6] * k, y[7] * k);
                    *(u32x4*)(O + (size_t)row * ldc + col0 + bj * HALF) = w; } }
    }
};
template <bool BASE_BF16, int ALPHA_X2, size_t SS_OFF> struct EpiResidB {
    static constexpr bool PERM = true, AFTER_DRAIN = false;
    const void* base; bf16_t* out; int ldc; unsigned char* wsb;
    __device__ __forceinline__ void operator()(const f32x4 (&acc)[2][2][4][2], const Unit& u, int wr, int wc, int fr, int fq) const {
        const int row0 = u.pm * BM + wr * 64 + fr; const int col0 = u.pn * BM + wc * 32 + 8 * fq; const int lane = fr + 16 * fq; constexpr float alpha = 0.5f * ALPHA_X2;
        float* ssp = (float*)(wsb + SS_OFF);
#pragma unroll
        for (int ai = 0; ai < 2; ++ai) {
            u32x4 bb[4][2]; f32x4 bf[4][2][2];
#pragma unroll
            for (int m = 0; m < 4; ++m) { const size_t ro = (size_t)(row0 + ai * HALF + m * 16) * ldc + col0;
#pragma unroll
                for (int bj = 0; bj < 2; ++bj) {
                    if (BASE_BF16) bb[m][bj] = *(const u32x4*)((const bf16_t*)base + ro + bj * HALF);
                    else { bf[m][bj][0] = *(const f32x4*)((const float*)base + ro + bj * HALF); bf[m][bj][1] = *(const f32x4*)((const float*)base + ro + bj * HALF + 4); } } }
            asm volatile("" ::: "memory");
#pragma unroll
            for (int m = 0; m < 4; ++m) { const int row = row0 + ai * HALF + m * 16; const size_t ro = (size_t)row * ldc + col0; float sq = 0.f;
#pragma unroll
                for (int bj = 0; bj < 2; ++bj) { f32x4 b0, b1;
                    if (BASE_BF16) { const u32x4 w = bb[m][bj]; b0 = (f32x4){bflo(w.x), bfhi(w.x), bflo(w.y), bfhi(w.y)}; b1 = (f32x4){bflo(w.z), bfhi(w.z), bflo(w.w), bfhi(w.w)}; }
                    else { b0 = bf[m][bj][0]; b1 = bf[m][bj][1]; }
                    const f32x4 v0 = b0 + acc[ai][bj][m][0] * alpha, v1 = b1 + acc[ai][bj][m][1] * alpha;
                    sq += ((v0[0] * v0[0] + v0[1] * v0[1]) + (v0[2] * v0[2] + v0[3] * v0[3])) + ((v1[0] * v1[0] + v1[1] * v1[1]) + (v1[2] * v1[2] + v1[3] * v1[3]));
                    u32x4 o; o.x = cvt_pk_bf16(v0[0], v0[1]); o.y = cvt_pk_bf16(v0[2], v0[3]); o.z = cvt_pk_bf16(v1[0], v1[1]); o.w = cvt_pk_bf16(v1[2], v1[3]);
                    *(u32x4*)(out + ro + bj * HALF) = o; }
                sq += __int_as_float(__builtin_amdgcn_ds_bpermute((lane ^ 16) << 2, __float_as_int(sq))); sq += __int_as_float(__builtin_amdgcn_ds_bpermute((lane ^ 32) << 2, __float_as_int(sq)));
                if (fq == 0) ssp[(size_t)row * 32 + u.pn * 4 + wc] = sq; }
            asm volatile("" ::: "memory");
        }
    }
};
}

namespace cg = cooperative_groups;
#define LAS __attribute__((address_space(3)))
#define DI __device__ __forceinline__
typedef unsigned short bf16_t;
typedef short bf16x8 __attribute__((ext_vector_type(8)));
typedef short s16x4 __attribute__((ext_vector_type(4)));
typedef float f32x4 __attribute__((ext_vector_type(4)));
typedef float f32x2 __attribute__((ext_vector_type(2)));
typedef float f32x16 __attribute__((ext_vector_type(16)));
typedef unsigned u32x4 __attribute__((ext_vector_type(4)));
typedef unsigned u32x2 __attribute__((ext_vector_type(2)));
typedef __bf16 bf16x2_t __attribute__((ext_vector_type(2)));

constexpr int BATCH = 8, SEQ = 2048, DM = 2048, DFF = 5632, INC = 6144, M = BATCH * SEQ;
constexpr float EPS = 1e-5f;
constexpr float LOG2E = 1.4426950408889634f;
constexpr float QSCALE = 0.08838834764831845f * LOG2E;
constexpr int NWAVES = 8, NTHREADS = 512;

constexpr size_t MiB = 1u << 20;
constexpr size_t WS_CTL = 0;
constexpr size_t WS_WGU1 = 1 * MiB, WS_WD1 = 45 * MiB, WS_WIN = 67 * MiB, WS_WOUT = 91 * MiB, WS_WGU2 = 99 * MiB, WS_WD2 = 143 * MiB;
constexpr size_t WS_XN = 166 * MiB;
constexpr size_t WS_BIG = 230 * MiB;
constexpr size_t WS_SSP = 422 * MiB;
constexpr size_t WS_END = 428 * MiB;
constexpr int RING_BYTES = 131072, MISC_OFF = RING_BYTES, LDS_BYTES = RING_BYTES + 1024 + 8192 + 8192;

DI unsigned cvtpk(float lo, float hi) { f32x2 v = {lo, hi}; bf16x2_t b = __builtin_convertvector(v, bf16x2_t); return __builtin_bit_cast(unsigned, b); }
DI float bf2f(unsigned short s) { return __uint_as_float((unsigned)s << 16); }
DI float shx(float v, int o, int lane) { return __int_as_float(__builtin_amdgcn_ds_bpermute((lane ^ o) << 2, __float_as_int(v))); }
DI float swap32(float v, int h) { auto rr = __builtin_amdgcn_permlane32_swap(__float_as_uint(v), __float_as_uint(v), false, false); return __uint_as_float(h ? rr[0] : rr[1]); }
DI float wave_sum(float v, int lane) {
#pragma unroll
    for (int o = 1; o < 64; o <<= 1) v += shx(v, o, lane);
    return v;
}
DI void block_sync() { asm volatile("s_waitcnt vmcnt(0) lgkmcnt(0)" ::: "memory"); __builtin_amdgcn_s_barrier(); asm volatile("" ::: "memory"); }

template <bool HAS_GAIN> DI void transpose_item(const float* __restrict__ W, int K, int N, bf16_t* __restrict__ WT, int mode, int slo, int shi, float scale, const float* __restrict__ kgain, LAS float* scr, int item, int lane) {
    asm volatile("" : "+v"(lane));
    const int nblk = N / 32, kb = item / nblk, nb = item % nblk, k0 = 64 * kb, n0 = 32 * nb;
    float gvec = 1.0f; if (HAS_GAIN) gvec = kgain[k0 + lane];
#pragma unroll 8
    for (int i = 0; i < 32; ++i) { const int kk = 2 * i + (lane >> 5); float wv = W[(size_t)(k0 + kk) * N + n0 + (lane & 31)];
        if (HAS_GAIN) { const float g0 = __uint_as_float(__builtin_amdgcn_readlane(__float_as_uint(gvec), 2 * i)), g1 = __uint_as_float(__builtin_amdgcn_readlane(__float_as_uint(gvec), 2 * i + 1)); wv *= (lane >> 5) ? g1 : g0; }
        scr[kk * 33 + (lane & 31)] = wv; }
    asm volatile("s_waitcnt lgkmcnt(0)" ::: "memory");
    const int c = lane & 7;
    const float sc = (n0 >= slo && n0 < shi) ? scale : 1.0f;
    const int rbase = mode == 0 ? n0 : ((n0 >> 7) * 256 + (n0 & 127) + (mode == 2 ? 128 : 0));
#pragma unroll
    for (int j = 0; j < 4; ++j) { const int n = (lane >> 3) + 8 * j; const LAS float* s = scr + (8 * c) * 33 + n;
        u32x4 o; o.x = cvtpk(s[0 * 33] * sc, s[1 * 33] * sc); o.y = cvtpk(s[2 * 33] * sc, s[3 * 33] * sc); o.z = cvtpk(s[4 * 33] * sc, s[5 * 33] * sc); o.w = cvtpk(s[6 * 33] * sc, s[7 * 33] * sc);
        *(u32x4*)(WT + (size_t)(rbase + n) * K + k0 + 8 * c) = o; }
    asm volatile("s_waitcnt lgkmcnt(0)" ::: "memory");
}

template <bool F32OUT> DI void rms_rows(const float* src, const float* __restrict__ gain, bf16_t* dstb, float* dstf, int gw, int NGW, int lane) {
    asm volatile("" : "+v"(lane));
    for (int m = gw; m < M; m += NGW) {
        const f32x4* xr = (const f32x4*)(src + (size_t)m * DM) + lane;
        f32x4 v[8]; float s = 0.f;
#pragma unroll
        for (int j = 0; j < 8; ++j) { v[j] = xr[64 * j]; s += (v[j].x * v[j].x + v[j].y * v[j].y) + (v[j].z * v[j].z + v[j].w * v[j].w); }
        const float rstd = 1.0f / sqrtf(wave_sum(s, lane) * (1.0f / DM) + EPS);
#pragma unroll
        for (int j = 0; j < 8; ++j) { const f32x4 g = ((const f32x4*)gain)[lane + 64 * j]; const f32x4 y = v[j] * rstd * g;
            if (F32OUT) ((f32x4*)(dstf + (size_t)m * DM))[lane + 64 * j] = y;
            else { u32x2 w; w.x = cvtpk(y.x, y.y); w.y = cvtpk(y.z, y.w); ((u32x2*)(dstb + (size_t)m * DM))[lane + 64 * j] = w; } }
    }
}

DI void build_rs(LAS float* rsl, const float* __restrict__ ssp, int fm, int wid, int lane) {
    asm volatile("" : "+v"(lane));
#pragma unroll 2
    for (int k = 0; k < 8; ++k) { const int rl = wid * 32 + (lane >> 1); const f32x4* p = (const f32x4*)(ssp + ((size_t)(fm + k) * 256 + rl) * 32 + (lane & 1) * 16);
        const f32x4 a = p[0], b = p[1], c = p[2], d = p[3]; float sm = ((a.x + a.y) + (a.z + a.w)) + ((b.x + b.y) + (b.z + b.w)) + ((c.x + c.y) + (c.z + c.w)) + ((d.x + d.y) + (d.z + d.w));
        sm += shx(sm, 1, lane);
        if ((lane & 1) == 0) rsl[k * 256 + rl] = 1.0f / sqrtf(sm * (1.0f / DM) + EPS); }
    block_sync();
}
DI void final_rows(float* __restrict__ out, const bf16_t* __restrict__ xb, const float* __restrict__ ssp, const float* __restrict__ gain, int gw, int NGW, int lane) {
    asm volatile("" : "+v"(lane));
    for (int m = gw; m < M; m += NGW) {
        const u32x4* xr = (const u32x4*)(xb + (size_t)m * DM) + lane;
        u32x4 raw[4];
#pragma unroll
        for (int j = 0; j < 4; ++j) raw[j] = xr[64 * j];
        const float rstd = 1.0f / sqrtf(wave_sum(lane < 32 ? ssp[(size_t)m * 32 + lane] : 0.f, lane) * (1.0f / DM) + EPS);
        f32x4* orow = (f32x4*)(out + (size_t)m * DM);
#pragma unroll
        for (int j = 0; j < 4; ++j) { const int c8 = lane + 64 * j; const f32x4 g0 = ((const f32x4*)gain)[2 * c8], g1 = ((const f32x4*)gain)[2 * c8 + 1]; const u32x4 w = raw[j];
            f32x4 y0 = {__uint_as_float(w.x << 16), __uint_as_float(w.x & 0xffff0000u), __uint_as_float(w.y << 16), __uint_as_float(w.y & 0xffff0000u)};
            f32x4 y1 = {__uint_as_float(w.z << 16), __uint_as_float(w.z & 0xffff0000u), __uint_as_float(w.w << 16), __uint_as_float(w.w & 0xffff0000u)};
            orow[2 * c8] = y0 * rstd * g0; orow[2 * c8 + 1] = y1 * rstd * g1; }
    }
}

DI void qknorm_rows(bf16_t* U, const float* __restrict__ qn, const float* __restrict__ kn, int gw, int NGW, int lane) {
    asm volatile("" : "+v"(lane));
    const int cw = lane & 15;
    for (int m = gw; m < M; m += NGW) {
        const int pos = m & (SEQ - 1);
        float cs[8], sn[8];
        if (cw < 4) {
#pragma unroll
            for (int e = 0; e < 8; ++e) { const int fi = 8 * (cw & 1) + e;
                const float invf = exp2f(-(float)fi * (18.931568569324174f / 16.0f));
                const float ang = (float)pos * invf;
                double rv = (double)ang * 0.15915494309189535; rv -= __builtin_rint(rv); const float fr = (float)rv;
                cs[e] = __builtin_amdgcn_cosf(fr); sn[e] = __builtin_amdgcn_sinf(fr); }
        } else {
#pragma unroll
            for (int e = 0; e < 8; ++e) { cs[e] = 1.f; sn[e] = 0.f; }
        }
        bf16_t* urow = U + (size_t)m * INC;
        u32x4 raws[4];
#pragma unroll
        for (int j = 0; j < 4; ++j) raws[j] = ((const u32x4*)urow)[lane + 64 * j];
#pragma unroll
        for (int j = 0; j < 4; ++j) {
            const u32x4 raw = raws[j];
            float v[8];
#pragma unroll
            for (int e = 0; e < 4; ++e) { v[2 * e] = __uint_as_float(raw[e] << 16); v[2 * e + 1] = __uint_as_float(raw[e] & 0xffff0000u); }
            float ss = 0.f;
#pragma unroll
            for (int e = 0; e < 8; ++e) ss += v[e] * v[e];
            ss += shx(ss, 1, lane); ss += shx(ss, 2, lane); ss += shx(ss, 4, lane); ss += shx(ss, 8, lane);
            const float rstd = 1.0f / sqrtf(ss * (1.0f / 128.0f) + EPS);
            const float* gp = (j < 2 ? qn : kn) + 8 * cw;
            const f32x4 g0 = *(const f32x4*)gp, g1 = *(const f32x4*)(gp + 4);
            float y[8];
#pragma unroll
            for (int e = 0; e < 8; ++e) y[e] = v[e] * rstd * (e < 4 ? g0[e] : g1[e - 4]);
            const float sgn = (cw < 2) ? -1.f : 1.f;
#pragma unroll
            for (int e = 0; e < 8; ++e) { const float yp = shx(y[e], 2, lane); y[e] = y[e] * cs[e] + sgn * yp * sn[e]; }
            if (j < 2) {
#pragma unroll
                for (int e = 0; e < 8; ++e) y[e] *= QSCALE;
            }
            u32x4 w; w.x = cvtpk(y[0], y[1]); w.y = cvtpk(y[2], y[3]); w.z = cvtpk(y[4], y[5]); w.w = cvtpk(y[6], y[7]);
            ((u32x4*)urow)[lane + 64 * j] = w;
        }
    }
}

namespace att {
constexpr int ULD = INC, STAGE = 65536;
constexpr float NEG = -1e30f;
DI int crow(int i, int h) { return (i & 3) + 8 * (i >> 2) + 4 * h; }
DI void glds16(const void* g, LAS unsigned char* l) { __builtin_amdgcn_global_load_lds((const unsigned*)g, (LAS unsigned*)l, 16, 0, 0); }
template <int MODE> DI void load_tile128(const bf16_t* g, LAS unsigned char* dst, int wid, int lane) {
#pragma unroll
    for (int t = 0; t < 2; ++t) { const int ci = wid + 8 * t, R = 4 * ci + (lane >> 4), cp = lane & 15;
        const int c = MODE == 0 ? (cp ^ (R & 15)) : ((((cp >> 2) ^ (R & 3)) << 2) | (cp & 3));
        glds16(g + (size_t)R * ULD + c * 8, dst + ci * 1024); }
}
DI void load_tile256(const bf16_t* g, LAS unsigned char* dst, int wid, int lane) {
#pragma unroll
    for (int t = 0; t < 4; ++t) { const int ci = wid + 8 * t, R = 2 * ci + (lane >> 5), cp = lane & 31;
        const int c = (((cp >> 2) ^ (R & 3)) << 2) | (cp & 3);
        glds16(g + (size_t)R * ULD + c * 8, dst + ci * 1024); }
}
DI s16x4 vtr(const LAS unsigned char* p) { typedef short v4i16_t __attribute__((ext_vector_type(4))); return __builtin_bit_cast(s16x4, __builtin_amdgcn_ds_read_tr16_b64_v4i16((LAS v4i16_t*)p)); }
DI bf16x8 pack8(const f32x16& x, int s) {
    u32x4 p; p.x = cvtpk(x[8 * s], x[8 * s + 1]); p.y = cvtpk(x[8 * s + 2], x[8 * s + 3]); p.z = cvtpk(x[8 * s + 4], x[8 * s + 5]); p.w = cvtpk(x[8 * s + 6], x[8 * s + 7]);
    return __builtin_bit_cast(bf16x8, p);
}
#define MFMA32(a, b, c) __builtin_amdgcn_mfma_f32_32x32x16_bf16((a), (b), (c), 0, 0, 0)
DI void qk_tile(f32x16 (&sT)[2], const LAS unsigned char* kimg, const bf16x8 (&qf)[8], int r, int h) {
    const LAS unsigned char* kp = kimg + r * 256; const int sw = r & 15;
    bf16x8 kf[2][2][2];
#define QK_LOAD(bt) do { _Pragma("unroll") for (int s2 = 0; s2 < 2; ++s2) _Pragma("unroll") for (int kb = 0; kb < 2; ++kb) \
        kf[(bt) & 1][s2][kb] = *(const LAS bf16x8*)(kp + kb * 8192 + (((2 * (2 * (bt) + s2) + h) ^ sw) << 4)); } while (0)
    QK_LOAD(0);
    f32x16 a0 = {}, a1 = {};
#pragma unroll
    for (int bt = 0; bt < 4; ++bt) {
        if (bt + 1 < 4) QK_LOAD(bt + 1);
        __builtin_amdgcn_sched_barrier(0);
#pragma unroll
        for (int s2 = 0; s2 < 2; ++s2) { a0 = MFMA32(kf[bt & 1][s2][0], qf[2 * bt + s2], a0); a1 = MFMA32(kf[bt & 1][s2][1], qf[2 * bt + s2], a1); }
        __builtin_amdgcn_sched_barrier(0);
    }
#undef QK_LOAD
    sT[0] = a0; sT[1] = a1;
}
DI f32x16 qk_half_lq(const LAS unsigned char* kimg32, const LAS unsigned char* qimg, int r, int h) {
    const int sw = r & 15; const LAS unsigned char* kp = kimg32 + r * 256; const LAS unsigned char* qp = qimg + r * 256;
    bf16x8 kf[2][2], qv[2][2];
#define QK_LOAD(bt) do { _Pragma("unroll") for (int s2 = 0; s2 < 2; ++s2) { const int co = (((2 * (2 * (bt) + s2) + h) ^ sw) << 4); qv[(bt) & 1][s2] = *(const LAS bf16x8*)(qp + co); \
        kf[(bt) & 1][s2] = *(const LAS bf16x8*)(kp + co); } } while (0)
    QK_LOAD(0);
    f32x16 a0 = {};
#pragma unroll
    for (int bt = 0; bt < 4; ++bt) {
        if (bt + 1 < 4) QK_LOAD(bt + 1);
        __builtin_amdgcn_sched_barrier(0);
#pragma unroll
        for (int s2 = 0; s2 < 2; ++s2) a0 = MFMA32(kf[bt & 1][s2], qv[bt & 1][s2], a0);
        __builtin_amdgcn_sched_barrier(0);
    }
#undef QK_LOAD
    return a0;
}
template <int RB> DI void pv_half(f32x16 (&o)[4], const f32x16& x, const LAS unsigned char* vimg, int lane, int kb) {
    const int h = lane >> 5, half = (lane >> 4) & 1, q = (lane & 15) >> 2, p = lane & 3;
    const LAS unsigned char* vb = vimg + (32 * kb + 4 * h + q) * RB + 32 * half + 8 * p;
    s16x4 lo[2][4], hi[2][4];
#pragma unroll
    for (int db = 0; db < 4; ++db) { const LAS unsigned char* a = vb + ((db ^ q) << 6); lo[0][db] = vtr(a); hi[0][db] = vtr(a + 8 * RB); }
#pragma unroll
    for (int s = 0; s < 2; ++s) {
        const bf16x8 pf = pack8(x, s);
        if (s == 0) {
#pragma unroll
            for (int db = 0; db < 4; ++db) { const LAS unsigned char* a = vb + ((db ^ q) << 6) + 16 * RB; lo[1][db] = vtr(a); hi[1][db] = vtr(a + 8 * RB); }
        }
        __builtin_amdgcn_sched_barrier(0);
#pragma unroll
        for (int db = 0; db < 4; ++db) { const bf16x8 vf = __builtin_shufflevector(lo[s][db], hi[s][db], 0, 1, 2, 3, 4, 5, 6, 7); o[db] = MFMA32(vf, pf, o[db]); }
        __builtin_amdgcn_sched_barrier(0);
    }
}
template <int RB> DI void pv_tile(f32x16 (&o)[4], const f32x16 (&sT)[2], const LAS unsigned char* vimg, int lane, int db0) {
    const int h = lane >> 5, half = (lane >> 4) & 1, q = (lane & 15) >> 2, p = lane & 3;
    const LAS unsigned char* vb = vimg + (4 * h + q) * RB + 32 * half + 8 * p;
    const LAS unsigned char* va[4];
#pragma unroll
    for (int db = 0; db < 4; ++db) va[db] = vb + (((db0 + db) ^ q) << 6);
    s16x4 lo[2][4], hi[2][4];
#pragma unroll
    for (int db = 0; db < 4; ++db) { lo[0][db] = vtr(va[db]); hi[0][db] = vtr(va[db] + 8 * RB); }
#pragma unroll
    for (int s = 0; s < 4; ++s) {
        const bf16x8 pf = pack8(sT[s >> 1], s & 1);
        if (s + 1 < 4) {
#pragma unroll
            for (int db = 0; db < 4; ++db) { lo[(s + 1) & 1][db] = vtr(va[db] + 16 * (s + 1) * RB); hi[(s + 1) & 1][db] = vtr(va[db] + 16 * (s + 1) * RB + 8 * RB); }
        }
        __builtin_amdgcn_sched_barrier(0);
#pragma unroll
        for (int db = 0; db < 4; ++db) { const bf16x8 vf = __builtin_shufflevector(lo[s & 1][db], hi[s & 1][db], 0, 1, 2, 3, 4, 5, 6, 7); o[db] = MFMA32(vf, pf, o[db]); }
        __builtin_amdgcn_sched_barrier(0);
    }
}

DI f32x16 qk_half(const LAS unsigned char* kimg32, const bf16x8 (&qf)[8], int r, int h) {
    const int sw = r & 15; const LAS unsigned char* kp = kimg32 + r * 256;
    bf16x8 kf[8];
#pragma unroll
    for (int s = 0; s < 8; ++s) kf[s] = *(const LAS bf16x8*)(kp + (((2 * s + h) ^ sw) << 4));
    f32x16 a0 = {};
#pragma unroll
    for (int s = 0; s < 8; ++s) a0 = MFMA32(kf[s], qf[s], a0);
    return a0;
}
DI void diff_unit(int bh, int qb, const bf16_t* __restrict__ U, bf16_t* __restrict__ AO, const float* __restrict__ subln, float lam, LAS unsigned char* lds, int wid, int lane) {
    asm volatile("" : "+v"(lane));
    const int b = bh >> 2, hd = bh & 3, r = lane & 31, h = lane >> 5, pi = wid >> 2, map = (wid >> 1) & 1, dh = wid & 1;
    const int q0w = qb * 64 + 32 * pi;
    const size_t rowbase = (size_t)b * SEQ;
    bf16x8 qf[8];
    { const bf16_t* Qp = U + (rowbase + q0w + r) * ULD + map * 512 + hd * 128 + h * 8;
#pragma unroll
      for (int s = 0; s < 8; ++s) qf[s] = *(const bf16x8*)(Qp + 16 * s); }
    const int NB = 2 * qb + 2, mynb = 2 * qb + pi + 1;
    const bf16_t* Kg1 = U + rowbase * ULD + 1024 + hd * 128;
    const bf16_t* Vg = U + rowbase * ULD + 2048 + hd * 256;
    unsigned offK, offV0, offV1;
    { const int R = 4 * wid + (lane >> 4), cp = lane & 15; offK = (unsigned)(R * ULD + ((cp ^ (R & 15)) << 3)); }
    { const int cp = lane & 31; const int R0 = 2 * wid + (lane >> 5), R1 = R0 + 16;
      offV0 = (unsigned)(R0 * ULD + (((((cp >> 2) ^ (R0 & 3)) << 2) | (cp & 3)) << 3)); offV1 = (unsigned)(R1 * ULD + (((((cp >> 2) ^ (R1 & 3)) << 2) | (cp & 3)) << 3)); }
#define DIFF_PIECE(j, p) do { const int jj_ = (j) < 63 ? (j) : 63; const size_t ko = (size_t)(32 * jj_) * ULD; LAS unsigned char* sp_ = lds + ((j) & 3) * 32768 + wid * 1024; \
        if ((p) == 0) glds16(Kg1 + ko + offK, sp_); else if ((p) == 1) glds16(Kg1 + 512 + ko + offK, sp_ + 8192); else if ((p) == 2) glds16(Vg + ko + offV0, sp_ + 16384); else glds16(Vg + ko + offV1, sp_ + 24576); } while (0)
#define DIFF_ISSUE(j) do { DIFF_PIECE(j, 0); DIFF_PIECE(j, 1); DIFF_PIECE(j, 2); DIFF_PIECE(j, 3); } while (0)
#define DIFF_SYNC() asm volatile("s_waitcnt vmcnt(4) lgkmcnt(0)\n\ts_barrier" ::: "memory")
    f32x16 o[4];
#pragma unroll
    for (int d = 0; d < 4; ++d) o[d] = (f32x16){};
    float mrun = NEG, lrun = 0.f;
    DIFF_ISSUE(0); DIFF_ISSUE(1); DIFF_ISSUE(2);
    asm volatile("s_waitcnt vmcnt(0) lgkmcnt(0)\n\ts_barrier" ::: "memory");
    f32x16 scur = qk_half(lds + map * 8192, qf, r, h);
    const int hq = lane >> 5, half = (lane >> 4) & 1, vq = (lane & 15) >> 2, vp = lane & 3;
    const int voff = 16384 + (4 * hq + vq) * 512 + 32 * half + 8 * vp;
    const int ksw = r & 15;
    constexpr float DIFF_THR = 8.0f;
#define DIFF_MAX() do { float mx = scur[0]; _Pragma("unroll") for (int i = 1; i < 16; ++i) mx = fmaxf(mx, scur[i]); mx = fmaxf(mx, swap32(mx, h)); const float mnew = fmaxf(mrun, mx); \
        if (__any(mnew > mrun + DIFF_THR)) { const float f = __builtin_amdgcn_exp2f(mrun - mnew); lrun *= f; _Pragma("unroll") for (int d = 0; d < 4; ++d) o[d] = o[d] * f; mrun = mnew; } } while (0)
#define DIFF_VREAD(j) do { const LAS unsigned char* vb = lds + ((j) & 3) * 32768 + voff; _Pragma("unroll") for (int s_ = 0; s_ < 2; ++s_) _Pragma("unroll") for (int db = 0; db < 4; ++db) { \
        const LAS unsigned char* a_ = vb + 16 * s_ * 512 + (((4 * dh + db) ^ vq) << 6); lo[s_][db] = vtr(a_); hi[s_][db] = vtr(a_ + 8 * 512); } } while (0)
#define DIFF_PV() do { _Pragma("unroll") for (int s_ = 0; s_ < 2; ++s_) { const bf16x8 pf = pack8(scur, s_); _Pragma("unroll") for (int db = 0; db < 4; ++db) { \
        const bf16x8 vf = __builtin_shufflevector(lo[s_][db], hi[s_][db], 0, 1, 2, 3, 4, 5, 6, 7); o[db] = MFMA32(vf, pf, o[db]); } } } while (0)
    int j = 0;
    for (; j < mynb - 1; ++j) {
        DIFF_MAX();
        DIFF_SYNC();
        bf16x8 kf[8]; s16x4 lo[2][4], hi[2][4];
        { const LAS unsigned char* kp = lds + ((j + 1) & 3) * 32768 + map * 8192 + r * 256;
#pragma unroll
          for (int s = 0; s < 8; ++s) kf[s] = *(const LAS bf16x8*)(kp + (((2 * s + h) ^ ksw) << 4)); }
        __builtin_amdgcn_sched_barrier(0);
        f32x16 sn = {}; float ps = 0.f;
        const LAS unsigned char* vbj = lds + (j & 3) * 32768 + voff;
#pragma unroll
        for (int s = 0; s < 8; ++s) {
            sn = MFMA32(kf[s], qf[s], sn);
            if (s < 4) {
#pragma unroll
                for (int s_ = 0; s_ < 2; ++s_) { const LAS unsigned char* a_ = vbj + 16 * s_ * 512 + (((4 * dh + s) ^ vq) << 6); lo[s_][s] = vtr(a_); hi[s_][s] = vtr(a_ + 8 * 512); }
            }
            if ((s & 1) == 0) DIFF_PIECE(j + 3, s >> 1);
            const float e0 = __builtin_amdgcn_exp2f(scur[2 * s] - mrun), e1 = __builtin_amdgcn_exp2f(scur[2 * s + 1] - mrun);
            scur[2 * s] = e0; scur[2 * s + 1] = e1; ps += e0 + e1;
            __builtin_amdgcn_sched_barrier(0);
        }
        lrun += ps;
        DIFF_PV();
        scur = sn;
    }
    {
#pragma unroll
        for (int i = 0; i < 16; ++i) if (crow(i, h) > r) scur[i] = NEG;
        DIFF_MAX();
        DIFF_SYNC();
        DIFF_ISSUE(j + 3);
        s16x4 lo[2][4], hi[2][4];
        DIFF_VREAD(j);
        float ps = 0.f;
#pragma unroll
        for (int i = 0; i < 16; ++i) { const float pe = __builtin_amdgcn_exp2f(scur[i] - mrun); scur[i] = pe; ps += pe; }
        lrun += ps;
        DIFF_PV();
        ++j;
    }
    for (; j < NB; ++j) { DIFF_SYNC(); DIFF_ISSUE(j + 3); }
#undef DIFF_MAX
#undef DIFF_VREAD
#undef DIFF_PV
#undef DIFF_SYNC
#undef DIFF_PIECE
#undef DIFF_ISSUE
    block_sync();
    const float ltot = lrun + swap32(lrun, h);
    LAS float* comb = (LAS float*)(lds + (pi * 2 + dh) * 16384) + lane;
    LAS float* ssb = (LAS float*)(lds + 65536);
    if (map == 1) {
        const float sc = lam / ltot;
#pragma unroll
        for (int d = 0; d < 4; ++d)
#pragma unroll
            for (int i = 0; i < 16; ++i) comb[(d * 16 + i) * 64] = o[d][i] * sc;
    }
    block_sync();
    if (map == 0) {
        const float sc = 1.0f / ltot; float ss = 0.f;
#pragma unroll
        for (int d = 0; d < 4; ++d)
#pragma unroll
            for (int i = 0; i < 16; ++i) { const float v = o[d][i] * sc - comb[(d * 16 + i) * 64]; o[d][i] = v; ss += v * v; }
        ss += swap32(ss, h);
        if (h == 0) ssb[(pi * 2 + dh) * 32 + r] = ss;
    }
    block_sync();
    if (map == 0) {
        const float ss = ssb[(pi * 2) * 32 + r] + ssb[(pi * 2 + 1) * 32 + r];
        const float rstd = 0.8f / sqrtf(ss * (1.0f / 256.0f) + EPS);
        bf16_t* orow = AO + (rowbase + q0w + r) * DM + hd * 256 + dh * 128 + 4 * h;
        const float* gp = subln + dh * 128 + 4 * h;
#pragma unroll
        for (int d = 0; d < 4; ++d)
#pragma unroll
            for (int g = 0; g < 4; ++g) { const f32x4 gv = *(const f32x4*)(gp + 32 * d + 8 * g);
                u32x2 w; w.x = cvtpk(o[d][4 * g] * rstd * gv.x, o[d][4 * g + 1] * rstd * gv.y); w.y = cvtpk(o[d][4 * g + 2] * rstd * gv.z, o[d][4 * g + 3] * rstd * gv.w);
                *(u32x2*)(orow + 32 * d + 8 * g) = w; }
    }
    block_sync();
}

template <bool MASKED> DI void sb_weights(f32x16& x, float& base, int kbase  , int qg, int h) {
    float L[16];
#pragma unroll
    for (int i = 0; i < 16; ++i) { const float z = x[i]; const float e = __builtin_amdgcn_exp2f(-fabsf(z));
        float l2 = -(fmaxf(z, 0.f) + __builtin_amdgcn_logf(1.0f + e));
        if (MASKED) { const int kg = kbase + crow(i, h); if (!(kg < qg)) l2 = 0.f; }
        L[i] = l2; if ((i & 7) == 7) __builtin_amdgcn_sched_barrier(0); }
    float T[4], To[4];
#pragma unroll
    for (int g = 0; g < 4; ++g) { L[4 * g + 2] += L[4 * g + 3]; L[4 * g + 1] += L[4 * g + 2]; L[4 * g] += L[4 * g + 1]; T[g] = L[4 * g]; To[g] = swap32(T[g], h); }
    float off[4]; float suf = 0.f;
#pragma unroll
    for (int g = 3; g >= 0; --g) { off[g] = suf + (h == 0 ? To[g] : 0.f); suf += T[g] + To[g]; }
#pragma unroll
    for (int i = 0; i < 16; ++i) { const float c = L[i] + off[i >> 2] + base; float a = __builtin_amdgcn_exp2f(x[i] + c);
        if (MASKED) { const int kg = kbase + crow(i, h); if (!(kg < qg)) a = 0.f; }
        x[i] = a; if ((i & 7) == 7) __builtin_amdgcn_sched_barrier(0); }
    base += suf;
}
constexpr float SB_CUT = 48.0f;
DI void sb_unit(int bh, int qb, const bf16_t* __restrict__ U, bf16_t* __restrict__ AO, LAS unsigned char* lds, int wid, int lane) {
    asm volatile("" : "+v"(lane));
    const int b = bh >> 3, hd = bh & 7, r = lane & 31, h = lane >> 5;
    const int q0w = qb * 256 + 32 * wid;
    const size_t rowbase = (size_t)b * SEQ;
    LAS unsigned char* qimg = lds + (wid < 4 ? 32768 + wid * 8192 : 98304 + (wid - 4) * 8192);
    { const bf16_t* Qp = U + (rowbase + q0w) * ULD + 3072 + hd * 128;
#pragma unroll
      for (int t = 0; t < 8; ++t) { const int Rr = 4 * t + (lane >> 4), cp = lane & 15; glds16(Qp + (size_t)Rr * ULD + ((cp ^ (Rr & 15)) << 3), qimg + t * 1024); } }
    const bf16_t* Kg = U + rowbase * ULD + 4096 + hd * 128;
    const bf16_t* Vg = U + rowbase * ULD + 5120 + hd * 128;
    const int NT = 4 * qb + 4;
    volatile LAS int* flags = (volatile LAS int*)(lds + MISC_OFF + 64);
    f32x16 o[4];
#pragma unroll
    for (int d = 0; d < 4; ++d) o[d] = (f32x16){};
    float R = 0.f;
#define SB_ISSUE(kt, st) do { const size_t ko = (size_t)(64 * (kt)) * ULD; LAS unsigned char* sp = lds + (st) * STAGE; \
        load_tile128<0>(Kg + ko, sp, wid, lane); load_tile128<1>(Vg + ko, sp + 16384, wid, lane); } while (0)
    SB_ISSUE(NT - 1, 0);
    const int qg = q0w + r;
    for (int ti = 0; ti < NT; ++ti) {
        const int kt = NT - 1 - ti;
        block_sync();
        if (ti > 0) { int alld = 1;
#pragma unroll
            for (int w = 0; w < 8; ++w) alld &= flags[((ti - 1) & 1) * 8 + w];
            if (alld) break; }
        if (ti + 1 < NT) SB_ISSUE(kt - 1, (ti + 1) & 1);
        int mydone = 0;
        if (64 * kt < q0w + 31) {
            if (!__all(R < -SB_CUT)) {
                const LAS unsigned char* sp = lds + (ti & 1) * STAGE;
                const bool masked = !(64 * kt + 63 < q0w);
#pragma unroll
                for (int kb = 1; kb >= 0; --kb) {
                    f32x16 x = qk_half_lq(sp + kb * 8192, qimg, r, h);
                    if (masked) sb_weights<true>(x, R, 64 * kt + 32 * kb, qg, h); else sb_weights<false>(x, R, 64 * kt + 32 * kb, qg, h);
                    pv_half<256>(o, x, sp + 16384, lane, kb);
                }
            }
            mydone = __all(R < -SB_CUT) ? 1 : 0;
        }
        if (lane == 0) flags[(ti & 1) * 8 + wid] = mydone;
    }
#undef SB_ISSUE
    bf16_t* orow = AO + (rowbase + q0w + r) * DM + 1024 + hd * 128 + 4 * h;
#pragma unroll
    for (int d = 0; d < 4; ++d)
#pragma unroll
        for (int g = 0; g < 4; ++g) { u32x2 w; w.x = cvtpk(o[d][4 * g], o[d][4 * g + 1]); w.y = cvtpk(o[d][4 * g + 2], o[d][4 * g + 3]); *(u32x2*)(orow + 32 * d + 8 * g) = w; }
    block_sync();
}
}

#define XB_TMO      128
#define XB_XCNT(j)  (256  + 64 * (j))
#define XB_XSUB(j)  (1280 + 64 * (j))
#define XB_XGEN(j)  (2304 + 64 * (j))
#define XB_TOP      3328
#define XB_TOPGEN   3392
#define XCD_BAR_WORDS 3456
#define XB_SPIN_CAP (1u << 18)

__device__ __forceinline__ unsigned xb_ld(unsigned* p)              { return __hip_atomic_load(p, __ATOMIC_RELAXED, __HIP_MEMORY_SCOPE_AGENT); }
__device__ __forceinline__ unsigned xb_add(unsigned* p, unsigned v) { return __hip_atomic_fetch_add(p, v, __ATOMIC_RELAXED, __HIP_MEMORY_SCOPE_AGENT); }
__device__ __forceinline__ unsigned xb_xcc_id() { return (unsigned)__builtin_amdgcn_s_getreg((3 << 11) | 20) & 0xFu; }
#define XB_SPIN(cond, bar) do { unsigned _sp = 0; while (cond) { __builtin_amdgcn_s_sleep(1); \
    if ((++_sp & 255u) == 0u) { if (xb_ld(&(bar)[XB_TMO])) break; if (_sp > XB_SPIN_CAP) { atomicAdd(&(bar)[XB_TMO], 1u); break; } } } } while (0)

struct XcdBarrier {
    unsigned* bar; unsigned x;
    volatile LAS unsigned* st;
};

__device__ __forceinline__ XcdBarrier xcd_barrier_post(unsigned* bar, volatile LAS unsigned* st) {
    XcdBarrier b; b.bar = bar; b.x = xb_xcc_id(); b.st = st;
    if (threadIdx.x == 0) (void)xb_add(&bar[XB_XCNT(b.x)], 1u);
    return b;
}
__device__ __forceinline__ void xcd_barrier_complete(unsigned* bar, unsigned x, unsigned& nloc, unsigned& nx) {
    const unsigned G = gridDim.x * gridDim.y * gridDim.z;
    unsigned sum, cnt, mine, sp = 0u;
    for (;;) {
        sum = 0u; cnt = 0u; mine = 0u;
#pragma unroll
        for (unsigned j = 0; j < 16; ++j) { const unsigned c = xb_ld(&bar[XB_XCNT(j)]); sum += c; cnt += (c > 0u) ? 1u : 0u; mine = (j == x) ? c : mine; }
        if (sum == G) break;
        __builtin_amdgcn_s_sleep(1);
        if ((++sp & 255u) == 0u) { if (xb_ld(&bar[XB_TMO])) break; if (sp > XB_SPIN_CAP) { atomicAdd(&bar[XB_TMO], 1u); break; } }
    }
    nloc = mine > 0u ? mine : 1u; nx = cnt > 0u ? cnt : 1u;
}

__device__ __forceinline__ void xcd_barrier(const XcdBarrier& b) {
    asm volatile("s_waitcnt vmcnt(0)" ::: "memory");
    __syncthreads();
    if (threadIdx.x == 0) {
        unsigned* bar = b.bar;
        __builtin_amdgcn_s_waitcnt(0);
        unsigned nloc = b.st[0], nx = b.st[1];
        if (nloc == 0u) { xcd_barrier_complete(bar, b.x, nloc, nx); b.st[0] = nloc; b.st[1] = nx; }
        const unsigned old = xb_add(&bar[XB_XSUB(b.x)], 1u);
        const unsigned gen = old / nloc;
        if (old + 1u == (gen + 1u) * nloc) {
            __builtin_amdgcn_fence(__ATOMIC_RELEASE, "agent");
            asm volatile("s_waitcnt vmcnt(0)" ::: "memory");
            const unsigned og = xb_add(&bar[XB_TOP], 1u);
            const unsigned tg = og / nx;
            if (og + 1u == (tg + 1u) * nx) xb_add(&bar[XB_TOPGEN], 1u);
            else XB_SPIN(xb_ld(&bar[XB_TOPGEN]) == tg, bar);
            __builtin_amdgcn_fence(__ATOMIC_ACQUIRE, "agent");
            xb_add(&bar[XB_XGEN(b.x)], 1u);
            asm volatile("s_waitcnt vmcnt(0)" ::: "memory");
        } else {
            XB_SPIN(xb_ld(&bar[XB_XGEN(b.x)]) == gen, bar);
            __builtin_amdgcn_fence(__ATOMIC_ACQUIRE, "agent");
            asm volatile("s_waitcnt vmcnt(0)" ::: "memory");
        }
    }
    __syncthreads();
}

struct Args { const float* in[20]; float* out; unsigned char* ws; };
enum { I_X = 0, I_N1, I_G1, I_U1, I_D1, I_NM, I_WIN, I_QN, I_KN, I_LQ1, I_LK1, I_LQ2, I_LK2, I_SUBLN, I_WOUT, I_N2, I_G2, I_U2, I_D2, I_NF };

__global__ void __launch_bounds__(NTHREADS, 2) fwd_megakernel(Args a) {
    extern __shared__ __attribute__((aligned(16))) unsigned char lds_raw[];
    LAS unsigned char* lds = (LAS unsigned char*)lds_raw;
    cg::grid_group grid = cg::this_grid();
    { volatile LAS unsigned* st0 = (volatile LAS unsigned*)(lds + MISC_OFF + 128); if (threadIdx.x == 0) { st0[0] = 0u; st0[1] = 0u; } __syncthreads(); }
    if (blockIdx.x == 0) for (int i = threadIdx.x; i < 16384; i += NTHREADS) ((unsigned*)(a.ws + WS_CTL))[i] = 0u;
#define GRID_BAR() xcd_barrier(xbar)
    const int G = gridDim.x, NGW = G * NWAVES;
    const int wid0 = __builtin_amdgcn_readfirstlane((int)threadIdx.x >> 6);
#define PHASE_IDS int lane = (int)__builtin_amdgcn_mbcnt_hi(~0u, __builtin_amdgcn_mbcnt_lo(~0u, 0u)); asm volatile("" : "+v"(lane)); const int wid = wid0, tid = wid * 64 + lane, gw = blockIdx.x * NWAVES + wid; (void)gw; (void)tid;
    unsigned char* ws = a.ws;
    unsigned* ctl = (unsigned*)(ws + WS_CTL);
    bf16_t* Wgu1 = (bf16_t*)(ws + WS_WGU1); bf16_t* Wd1 = (bf16_t*)(ws + WS_WD1); bf16_t* Win = (bf16_t*)(ws + WS_WIN); bf16_t* Wout = (bf16_t*)(ws + WS_WOUT);
    bf16_t* Wgu2 = (bf16_t*)(ws + WS_WGU2); bf16_t* Wd2 = (bf16_t*)(ws + WS_WD2);
    bf16_t* XN = (bf16_t*)(ws + WS_XN); bf16_t* BIG = (bf16_t*)(ws + WS_BIG);
    bf16_t* X1B = (bf16_t*)a.out; bf16_t* X2B = (bf16_t*)a.out + (size_t)M * DM;
    float* SSP = (float*)(ws + WS_SSP); LAS float* rsl = (LAS float*)(lds + pg8::RS_LDS_OFF);
    float* X = a.out;

    {
        PHASE_IDS
        LAS float* scr = (LAS float*)(lds + wid * 16384);
        constexpr int I_FF = (DM / 64) * (DFF / 32), I_DN = (DFF / 64) * (DM / 32), I_IN = (DM / 64) * (INC / 32), I_OUT = (DM / 64) * (DM / 32);
        constexpr int NITEMS = 4 * I_FF + 2 * I_DN + I_IN + I_OUT;
        for (int it = gw; it < NITEMS; it += NGW) {
            int r = it;
            if (r < I_FF) { transpose_item<false>(a.in[I_G1], DM, DFF, Wgu1, 1, 0, 0, 1.f, nullptr, scr, r, lane); continue; } r -= I_FF;
            if (r < I_FF) { transpose_item<false>(a.in[I_U1], DM, DFF, Wgu1, 2, 0, 0, 1.f, nullptr, scr, r, lane); continue; } r -= I_FF;
            if (r < I_DN) { transpose_item<false>(a.in[I_D1], DFF, DM, Wd1, 0, 0, 0, 1.f, nullptr, scr, r, lane); continue; } r -= I_DN;
            if (r < I_IN) { transpose_item<true>(a.in[I_WIN], DM, INC, Win, 0, 3072, 4096, QSCALE, a.in[I_NM], scr, r, lane); continue; } r -= I_IN;
            if (r < I_OUT) { transpose_item<false>(a.in[I_WOUT], DM, DM, Wout, 0, 0, 0, 1.f, nullptr, scr, r, lane); continue; } r -= I_OUT;
            if (r < I_FF) { transpose_item<true>(a.in[I_G2], DM, DFF, Wgu2, 1, 0, 0, 1.f, a.in[I_N2], scr, r, lane); continue; } r -= I_FF;
            if (r < I_FF) { transpose_item<true>(a.in[I_U2], DM, DFF, Wgu2, 2, 0, 0, 1.f, a.in[I_N2], scr, r, lane); continue; } r -= I_FF;
            transpose_item<false>(a.in[I_D2], DFF, DM, Wd2, 0, 0, 0, 1.f, nullptr, scr, r, lane);
        }
        rms_rows<false>(a.in[I_X], a.in[I_N1], XN, nullptr, gw, NGW, lane);
    }
    grid.sync();
    const XcdBarrier xbar = xcd_barrier_post((unsigned*)(a.ws + WS_CTL) + 4096, (volatile LAS unsigned*)(lds + MISC_OFF + 128));
    { pg8::Gemm g{XN, Wgu1, M, 2 * DFF, DM}; pg8::StaticOrder S; S.init(M, 2 * DFF, G, (int)blockIdx.x); pg8::EpiSwiGLU<false> E{BIG, DFF, rsl};
      pg8::gemm_phase<pg8::EpiSwiGLU<false>, pg8::StaticOrder, true, true>(lds, g, S, E, wid0); }
    GRID_BAR();
    { pg8::Gemm g{BIG, Wd1, M, DM, DFF}; pg8::StaticOrder S; S.init(M, DM, G, (int)blockIdx.x); typedef pg8::EpiResidB<false, 1, WS_SSP> Epi2; Epi2 E{a.in[I_X], X1B, DM, ws};
      pg8::gemm_phase<Epi2, pg8::StaticOrder, true, true>(lds, g, S, E, wid0); }
    GRID_BAR();
    { pg8::Gemm g{X1B, Win, M, INC, DM}; pg8::StaticOrder S; S.init(M, INC, G, (int)blockIdx.x); pg8::EpiQKV E{BIG, rsl, a.in[I_QN], a.in[I_KN]};
      { PHASE_IDS pg8::Unit u0; if (S.next(0, u0)) build_rs(rsl, SSP, u0.pm & ~7, wid, lane); else block_sync(); }
      pg8::gemm_phase<pg8::EpiQKV, pg8::StaticOrder, true, true>(lds, g, S, E, wid0); }
    GRID_BAR();
    {
        PHASE_IDS
        float lam;
        { const float p1 = a.in[I_LQ1][lane] * a.in[I_LK1][lane] + a.in[I_LQ1][lane + 64] * a.in[I_LK1][lane + 64];
          const float p2 = a.in[I_LQ2][lane] * a.in[I_LK2][lane] + a.in[I_LQ2][lane + 64] * a.in[I_LK2][lane + 64];
          lam = expf(wave_sum(p1, lane)) - expf(wave_sum(p2, lane)) + 0.2f; }
        volatile LAS int* sh = (volatile LAS int*)(lds + MISC_OFF);
        const int myx = (int)(__builtin_amdgcn_s_getreg((3 << 11) | 20) & 7u);
        for (int k = 0; k < 8; ++k) {
            const int qx = (myx + k) & 7; unsigned* cnt = ctl + 64 * (1 + qx);
            if (k == 1) { if (tid < 8) sh[8 + tid] = (int)__hip_atomic_load(ctl + 64 * (1 + tid), __ATOMIC_RELAXED, __HIP_MEMORY_SCOPE_AGENT); block_sync(); }
            if (k > 0 && sh[8 + qx] >= 128) continue;
            for (;;) {
                if (tid == 0) sh[0] = (int)atomicAdd(cnt, 1u);
                block_sync();
                const int idx = sh[0];
                block_sync();
                if (idx >= 128) break;
#ifndef NO_DIFF
                if (idx < 64) { const int sl = idx & 31, dbh = qx * 4 + 2 * (idx >> 5) + (sl >> 4), qi = sl & 15;
                    for (int rep = 0; rep < 2; ++rep) att::diff_unit(dbh, rep ? 31 - qi : qi, BIG, XN, a.in[I_SUBLN], lam, lds, wid, lane); }
#endif
#ifndef NO_SB
                if (idx >= 64) att::sb_unit(qx * 8 + ((idx - 64) >> 3), 7 - ((idx - 64) & 7), BIG, XN, lds, wid, lane);
#endif
            }
        }
    }
    GRID_BAR();
    { pg8::Gemm g{XN, Wout, M, DM, DM}; pg8::StaticOrder S; S.init(M, DM, G, (int)blockIdx.x); typedef pg8::EpiResidB<true, 2, WS_SSP + 2 * MiB> Epi4; Epi4 E{X1B, X2B, DM, ws};
      pg8::gemm_phase<Epi4, pg8::StaticOrder, true, true>(lds, g, S, E, wid0); }
    GRID_BAR();
    { pg8::Gemm g{X2B, Wgu2, M, 2 * DFF, DM}; pg8::StaticOrder S; S.init(M, 2 * DFF, G, (int)blockIdx.x); pg8::EpiSwiGLU<true> E{BIG, DFF, rsl};
      { PHASE_IDS pg8::Unit u0; if (S.next(0, u0)) build_rs(rsl, SSP + (size_t)M * 32, u0.pm & ~7, wid, lane); else block_sync(); }
      pg8::gemm_phase<pg8::EpiSwiGLU<true>, pg8::StaticOrder, true, true>(lds, g, S, E, wid0); }
    GRID_BAR();
    { pg8::Gemm g{BIG, Wd2, M, DM, DFF}; pg8::StaticOrder S; S.init(M, DM, G, (int)blockIdx.x); typedef pg8::EpiResidB<true, 1, WS_SSP + 4 * MiB> Epi6; Epi6 E{X2B, XN, DM, ws};
      pg8::gemm_phase<Epi6, pg8::StaticOrder, true, true>(lds, g, S, E, wid0); }
    GRID_BAR();
    { PHASE_IDS final_rows(X, XN, SSP + (size_t)M * 64, a.in[I_NF], gw, NGW, lane); }
}

extern "C" void kernel_launch(void* const* d_in, const int* in_sizes, int n_in, void* d_out, int out_size, void* d_ws, size_t ws_size, hipStream_t stream) {
    static int grid = 0;
    if (grid == 0) {
        if (n_in != 20 || out_size != M * DM || ws_size < WS_END) { fprintf(stderr, "kernel_launch: unexpected problem (n_in %d out %d ws %zu)\n", n_in, out_size, ws_size); grid = -1; return; }
        int dev = 0, cus = 0, per_cu = 0;
        (void)hipGetDevice(&dev); (void)hipDeviceGetAttribute(&cus, hipDeviceAttributeMultiprocessorCount, dev);
        (void)hipFuncSetAttribute((const void*)fwd_megakernel, hipFuncAttributeMaxDynamicSharedMemorySize, LDS_BYTES);
        (void)hipOccupancyMaxActiveBlocksPerMultiprocessor(&per_cu, (const void*)fwd_megakernel, NTHREADS, LDS_BYTES);
        if (per_cu < 1) { fprintf(stderr, "kernel_launch: occupancy query says %d blocks per CU\n", per_cu); per_cu = 1; }
        grid = cus * 1;
        (void)hipGetLastError();
    }
    if (grid < 0) return;
    Args a{};
    for (int i = 0; i < 20; ++i) a.in[i] = (const float*)d_in[i];
    a.out = (float*)d_out; a.ws = (unsigned char*)d_ws;
    void* args[] = {&a};
    hipError_t e = hipLaunchCooperativeKernel((const void*)fwd_megakernel, dim3(grid), dim3(NTHREADS), args, LDS_BYTES, stream);
    if (e != hipSuccess) fprintf(stderr, "cooperative launch failed: %s (grid %d)\n", hipGetErrorString(e), grid);
}
```

```cpp
#include <hip/hip_cooperative_groups.h>
#include <hip/hip_runtime.h>
#include <cstdio>
#include <cstdint>
namespace pg8 {
#define PG8_LAS __attribute__((address_space(3)))
typedef unsigned short bf16_t;
typedef short bf16x8 __attribute__((ext_vector_type(8)));
typedef float f32x4 __attribute__((ext_vector_type(4)));
typedef unsigned u32x4 __attribute__((ext_vector_type(4)));
constexpr int BM = 256, BK = 64, HALF = 128, HTB = HALF * BK * 2  , STAGE_BYTES = 8 * HTB, NXCD = 8, WGM = 8;

__host__ __device__ __forceinline__ int lds_byte(int r, int c) { const int st = (r >> 4) * 2 + (c >> 5), rr = r & 15, cc = c & 31, ob = rr * 64 + cc * 2; return st * 1024 + (ob ^ (((ob >> 9) & 1) << 5)); }
__host__ __device__ __forceinline__ void stage_rc(int b, int& R, int& C) { const int st = b / 1024, sb = b % 1024, swz = sb ^ (((sb >> 9) & 1) << 5); R = (st >> 1) * 16 + swz / 64; C = (st & 1) * 32 + (swz % 64) / 2; }
__host__ __device__ __forceinline__ int perm32(int rho) { const int n = rho >> 4, i = rho & 15; return 8 * (i >> 2) + 4 * n + (i & 3); }

struct Unit { int pm, pn; };
struct Gemm { const bf16_t* A; const bf16_t* Bt; int M, N, K; };

struct StaticOrder {
    int nM, nN, nwg, G, c;
    __host__ __device__ void init(int M, int N, int G_, int c_) { nM = M / BM; nN = N / BM; nwg = nM * nN; G = G_; c = c_; }
    __host__ __device__ bool next(int i, Unit& u) const {
        const long L = (long)i * G + c; if (L >= nwg) return false;
        int wgid = (int)L; { const int q = nwg / NXCD, r = nwg % NXCD, xcd = wgid % NXCD, off = wgid / NXCD; wgid = (xcd < r ? xcd * (q + 1) : r * (q + 1) + (xcd - r) * q) + off; }
        const int nig = WGM * nN, gid = wgid / nig, fm = gid * WGM, gsz = (nM - fm) < WGM ? (nM - fm) : WGM;
        u.pm = fm + ((wgid % nig) % gsz); u.pn = (wgid % nig) / gsz; return true;
    }
    __device__ __forceinline__ void a_ready(const Unit&) const {}
    __device__ __forceinline__ void done(const Unit&) const {}
};

__device__ __forceinline__ unsigned cvt_pk_bf16(float lo, float hi) { unsigned r; asm volatile("v_cvt_pk_bf16_f32 %0, %1, %2" : "=v"(r) : "v"(lo), "v"(hi)); return r; }
typedef float f32x2 __attribute__((ext_vector_type(2)));
__device__ __forceinline__ f32x2 gelu_pk(f32x2 v) {
    const f32x2 av = __builtin_elementwise_abs(v), d = av * 0.2316418882f + 1.0f;
    f32x2 t; t.x = __builtin_amdgcn_rcpf(d.x); t.y = __builtin_amdgcn_rcpf(d.y);
    f32x2 q = t * 0.5307027145f + (-0.7265760135f); q = q * t + 0.7107068705f; q = q * t + (-0.142248368f); q = q * t + 0.127414796f; q = q * t;
    const f32x2 s = (v * v) * (-0.72134752044f);
    f32x2 e; e.x = __builtin_amdgcn_exp2f(s.x); e.y = __builtin_amdgcn_exp2f(s.y);
    const f32x2 m = v * (q * e), r = v - m;
    f32x2 o; o.x = v.x < 0.f ? m.x : r.x; o.y = v.y < 0.f ? m.y : r.y; return o;
}

template <int ACT  > struct EpiBf16 {
    static constexpr bool PERM = true, AFTER_DRAIN = false; static_assert(ACT == 0 || ACT == 1, "EpiBf16: ACT is 0 (none) or 1 (gelu_pk)");
    bf16_t* O; int ldc; const float* bias; int split_cols; size_t split_stride; float scale0;
    __device__ __forceinline__ void operator()(const f32x4 (&acc)[2][2][4][2], const Unit& u, int wr, int wc, int fr, int fq) const {
        const int row0 = u.pm * BM + wr * 64 + fr; int colt = u.pn * BM; bf16_t* base = O;
        float sc = 1.f; if (split_cols) { const int t = colt / split_cols; base += (size_t)t * split_stride; colt -= t * split_cols; if (t == 0) sc = scale0; }
        const int col0 = colt + wc * 32 + 8 * fq, bcol0 = u.pn * BM + wc * 32 + 8 * fq;
        f32x4 bv[2][2];
#pragma unroll
        for (int bj = 0; bj < 2; ++bj)
#pragma unroll
            for (int n = 0; n < 2; ++n) bv[bj][n] = bias ? *(const f32x4*)(bias + bcol0 + bj * HALF + 4 * n) : (f32x4){0.f, 0.f, 0.f, 0.f};
#pragma unroll
        for (int ai = 0; ai < 2; ++ai)
#pragma unroll
            for (int m = 0; m < 4; ++m) { bf16_t* rowp = base + (size_t)(row0 + ai * HALF + m * 16) * ldc + col0;
#pragma unroll
                for (int bj = 0; bj < 2; ++bj) { f32x4 v0 = acc[ai][bj][m][0] + bv[bj][0], v1 = acc[ai][bj][m][1] + bv[bj][1];
                    if (ACT == 1) { f32x2 a = gelu_pk((f32x2){v0[0], v0[1]}), b = gelu_pk((f32x2){v0[2], v0[3]}), c = gelu_pk((f32x2){v1[0], v1[1]}), d = gelu_pk((f32x2){v1[2], v1[3]});
                        v0 = (f32x4){a.x, a.y, b.x, b.y}; v1 = (f32x4){c.x, c.y, d.x, d.y}; }
                    v0 = v0 * sc; v1 = v1 * sc; u32x4 w; w.x = cvt_pk_bf16(v0[0], v0[1]); w.y = cvt_pk_bf16(v0[2], v0[3]); w.z = cvt_pk_bf16(v1[0], v1[1]); w.w = cvt_pk_bf16(v1[2], v1[3]);
                    *(u32x4*)(rowp + bj * HALF) = w; } }
    }
};

template <class Epi, class Sched, bool ALIGN_EPI = false, bool SP2 = false>
__device__ __forceinline__ void gemm_phase(PG8_LAS unsigned char* lds, const Gemm g, const Sched S, const Epi E, int wid0) {
    int tid_ = wid0 * 64 + (int)__builtin_amdgcn_mbcnt_hi(~0u, __builtin_amdgcn_mbcnt_lo(~0u, 0u)); asm volatile("" : "+v"(tid_));
    const int tid = tid_, wid = __builtin_amdgcn_readfirstlane(tid >> 6), lane = tid & 63, wr = wid >> 2, wc = wid & 3, fr = lane & 15, fq = lane >> 4;
    const int K = g.K, nt = K / BK;
    unsigned voffA[2], voffB[2];
#pragma unroll
    for (int i = 0; i < 2; ++i) { int R, C; stage_rc(tid * 16 + i * 8192, R, C); const int Rb = Epi::PERM ? ((R & ~31) + perm32(R & 31)) : R;
        voffA[i] = (unsigned)(R * K + C) * 2u; voffB[i] = (unsigned)(Rb * K + C) * 2u; }
    const size_t kstep = (size_t)(BK * 2);
    const size_t hstep = (size_t)HALF * K * 2;
    const size_t tstep = 2 * hstep;
    const unsigned ldsw = (unsigned)wid * 1024u;
    const int aoff = lds_byte(wr * 64 + fr, fq * 8), boff = lds_byte(wc * 32 + fr, fq * 8);
#define PG8_SA(b, h) (((b) * 2 + (h)) * HTB)
#define PG8_SB(b, h) ((4 + (b) * 2 + (h)) * HTB)
#define PG8_STAGE(bufoff, gbase, voff) do { _Pragma("unroll") for (int _i = 0; _i < 2; ++_i) \
        __builtin_amdgcn_global_load_lds((const unsigned*)((const char*)(gbase) + (voff)[_i]), (PG8_LAS unsigned*)(lds + (bufoff) + ldsw + _i * 8192), 16, 0, 0); } while (0)
#define PG8_LDA(dst, b, h) do { _Pragma("unroll") for (int m = 0; m < 4; ++m) _Pragma("unroll") for (int k = 0; k < 2; ++k) dst[m][k] = *(const PG8_LAS bf16x8*)(lds + PG8_SA(b, h) + aoff + m * 2048 + k * 1024); } while (0)
#define PG8_LDB(dst, b, h) do { _Pragma("unroll") for (int n = 0; n < 2; ++n) _Pragma("unroll") for (int k = 0; k < 2; ++k) dst[n][k] = *(const PG8_LAS bf16x8*)(lds + PG8_SB(b, h) + boff + n * 2048 + k * 1024); } while (0)
#define PG8_MMA(ai, bj, At, Bt) do { __builtin_amdgcn_s_setprio(1); _Pragma("unroll") for (int m = 0; m < 4; ++m) _Pragma("unroll") for (int n = 0; n < 2; ++n) _Pragma("unroll") for (int k = 0; k < 2; ++k) \
        acc[ai][bj][m][n] = __builtin_amdgcn_mfma_f32_16x16x32_bf16(Bt[n][k], At[m][k], acc[ai][bj][m][n], 0, 0, 0); __builtin_amdgcn_s_setprio(0); } while (0)
#define PG8_WAIT_V(n) asm volatile("s_waitcnt vmcnt(" #n ")" ::: "memory")
#define PG8_WAIT_L(n) asm volatile("s_waitcnt lgkmcnt(" #n ")" ::: "memory")
#define PG8_BAR __builtin_amdgcn_s_barrier()
#define PG8_SCHED __builtin_amdgcn_sched_barrier(0)
    Unit cur, nxt; int ui = 0;
    if (!S.next(0, cur)) return;
    f32x4 acc[2][2][4][2];
#pragma unroll
    for (int a = 0; a < 2; ++a)
#pragma unroll
        for (int b = 0; b < 2; ++b)
#pragma unroll
            for (int m = 0; m < 4; ++m)
#pragma unroll
                for (int n = 0; n < 2; ++n) acc[a][b][m][n] = (f32x4){0.f, 0.f, 0.f, 0.f};
    bf16x8 At[4][2], B0[2][2], B1[2][2];
    const char* cA = (const char*)g.A + (size_t)cur.pm * tstep; const char* cB = (const char*)g.Bt + (size_t)cur.pn * tstep;
    S.a_ready(cur);
    if constexpr (SP2) {
        PG8_STAGE(PG8_SB(0, 0), cB, voffB); PG8_STAGE(PG8_SB(0, 1), cB + hstep, voffB); PG8_STAGE(PG8_SA(0, 0), cA, voffA); PG8_STAGE(PG8_SA(0, 1), cA + hstep, voffA);
        if (wr == 1) PG8_BAR;
        PG8_WAIT_V(2); PG8_BAR;
        PG8_STAGE(PG8_SB(1, 0), cB + kstep, voffB); PG8_STAGE(PG8_SA(1, 0), cA + kstep, voffA); PG8_STAGE(PG8_SB(1, 1), cB + hstep + kstep, voffB);
        PG8_WAIT_V(6); PG8_BAR;
    } else {
        PG8_STAGE(PG8_SB(0, 0), cB, voffB); PG8_STAGE(PG8_SA(0, 0), cA, voffA); PG8_STAGE(PG8_SB(0, 1), cB + hstep, voffB); PG8_STAGE(PG8_SA(0, 1), cA + hstep, voffA);
        if (wr == 1) PG8_BAR;
        PG8_WAIT_V(4); PG8_BAR;
        PG8_STAGE(PG8_SB(1, 0), cB + kstep, voffB); PG8_STAGE(PG8_SA(1, 0), cA + kstep, voffA); PG8_STAGE(PG8_SB(1, 1), cB + hstep + kstep, voffB);
        PG8_WAIT_V(6); PG8_BAR;
    }
    for (;;) {
        const bool has_next = S.next(ui + 1, nxt);
        const char* nA = has_next ? (const char*)g.A + (size_t)nxt.pm * tstep : cA; const char* nB = has_next ? (const char*)g.Bt + (size_t)nxt.pn * tstep : cB;
        for (int t = 0; t < nt; t += 2) {
            const bool last = (t == nt - 2);
            const char* a1 = cA + (size_t)(t + 1) * kstep;
            const char* a2 = last ? nA : cA + (size_t)(t + 2) * kstep; const char* b2 = last ? nB : cB + (size_t)(t + 2) * kstep;
            const char* a3 = a2 + kstep; const char* b3 = b2 + kstep;
            if (last && has_next) S.a_ready(nxt);
            if constexpr (SP2) {
            PG8_LDB(B0, 0, 0); PG8_LDB(B1, 0, 1); PG8_SCHED; PG8_LDA(At, 0, 0); PG8_STAGE(PG8_SA(1, 1), a1 + hstep, voffA);
            PG8_WAIT_V(8); PG8_WAIT_L(0); PG8_BAR; PG8_MMA(0, 0, At, B0); PG8_MMA(0, 1, At, B1); PG8_BAR; PG8_SCHED;
            PG8_LDA(At, 0, 1); PG8_STAGE(PG8_SB(0, 0), b2, voffB); PG8_STAGE(PG8_SB(0, 1), b2 + hstep, voffB); PG8_STAGE(PG8_SA(0, 0), a2, voffA);
            PG8_WAIT_V(8); PG8_WAIT_L(0); PG8_BAR; PG8_MMA(1, 0, At, B0); PG8_MMA(1, 1, At, B1); PG8_BAR; PG8_SCHED;
            PG8_LDB(B0, 1, 0); PG8_LDB(B1, 1, 1); PG8_SCHED; PG8_LDA(At, 1, 0); PG8_STAGE(PG8_SA(0, 1), a2 + hstep, voffA);
            PG8_WAIT_V(8); PG8_WAIT_L(0); PG8_BAR; PG8_MMA(0, 0, At, B0); PG8_MMA(0, 1, At, B1); PG8_BAR; PG8_SCHED;
            PG8_LDA(At, 1, 1); PG8_STAGE(PG8_SB(1, 0), b3, voffB); PG8_STAGE(PG8_SB(1, 1), b3 + hstep, voffB); PG8_STAGE(PG8_SA(1, 0), a3, voffA);
            PG8_WAIT_V(8); PG8_WAIT_L(0); PG8_BAR; PG8_MMA(1, 0, At, B0); PG8_MMA(1, 1, At, B1); PG8_BAR; PG8_SCHED;
            } else {
            PG8_LDB(B0, 0, 0); PG8_SCHED; PG8_LDA(At, 0, 0); PG8_STAGE(PG8_SA(1, 1), a1 + hstep, voffA);
            PG8_WAIT_L(8); PG8_BAR; PG8_WAIT_L(0); PG8_MMA(0, 0, At, B0); PG8_BAR; PG8_SCHED;
            PG8_LDB(B1, 0, 1); PG8_STAGE(PG8_SB(0, 0), b2, voffB);
            PG8_BAR; PG8_WAIT_L(0); PG8_MMA(0, 1, At, B1); PG8_BAR;
            PG8_LDA(At, 0, 1); PG8_STAGE(PG8_SA(0, 0), a2, voffA);
            PG8_BAR; PG8_WAIT_L(0); PG8_MMA(1, 0, At, B0); PG8_BAR; PG8_SCHED;
            PG8_STAGE(PG8_SB(0, 1), b2 + hstep, voffB);
            PG8_WAIT_V(6); PG8_BAR; PG8_MMA(1, 1, At, B1); PG8_BAR;
            PG8_LDB(B0, 1, 0); PG8_SCHED; PG8_LDA(At, 1, 0); PG8_STAGE(PG8_SA(0, 1), a2 + hstep, voffA);
            PG8_WAIT_L(8); PG8_BAR; PG8_WAIT_L(0); PG8_MMA(0, 0, At, B0); PG8_BAR; PG8_SCHED;
            PG8_LDB(B1, 1, 1); PG8_STAGE(PG8_SB(1, 0), b3, voffB);
            PG8_BAR; PG8_WAIT_L(0); PG8_MMA(0, 1, At, B1); PG8_BAR;
            PG8_LDA(At, 1, 1); PG8_STAGE(PG8_SA(1, 0), a3, voffA);
            PG8_BAR; PG8_WAIT_L(0); PG8_MMA(1, 0, At, B0); PG8_BAR; PG8_SCHED;
            PG8_STAGE(PG8_SB(1, 1), b3 + hstep, voffB);
            PG8_WAIT_V(6); PG8_BAR; PG8_MMA(1, 1, At, B1); PG8_BAR;
            }
        }
        if constexpr (ALIGN_EPI) { if (wr == 0) PG8_BAR; }
        if constexpr (!Epi::AFTER_DRAIN) { E(acc, cur, wr, wc, fr, fq); S.done(cur); }
        if (!has_next) break;
#pragma unroll
        for (int a = 0; a < 2; ++a)
#pragma unroll
            for (int b = 0; b < 2; ++b)
#pragma unroll
                for (int m = 0; m < 4; ++m)
#pragma unroll
                    for (int n = 0; n < 2; ++n) acc[a][b][m][n] = (f32x4){0.f, 0.f, 0.f, 0.f};
        cur = nxt; cA = nA; cB = nB; ++ui;
        if constexpr (ALIGN_EPI) { if (wr == 1) PG8_BAR; }
    }
    PG8_WAIT_V(0);
    if constexpr (!ALIGN_EPI) { if (wr == 0) PG8_BAR; }
    PG8_BAR;
    if constexpr (Epi::AFTER_DRAIN) { E.fused(acc, cur, wr, wc, fr, fq, lds, wid, lane); S.done(cur); }
#undef PG8_SA
#undef PG8_SB
#undef PG8_STAGE
#undef PG8_LDA
#undef PG8_LDB
#undef PG8_MMA
#undef PG8_WAIT_V
#undef PG8_WAIT_L
#undef PG8_BAR
#undef PG8_SCHED
}
}
namespace pg8 {
constexpr int RS_LDS_OFF = 131072 + 1024;
__device__ __forceinline__ float bflo(unsigned w) { return __uint_as_float(w << 16); }
__device__ __forceinline__ float bfhi(unsigned w) { return __uint_as_float(w & 0xffff0000u); }
template <bool HAS_RS> struct EpiSwiGLU {
    static constexpr bool PERM = true, AFTER_DRAIN = false;
    bf16_t* O; int ldc; PG8_LAS const float* rsl;
    __device__ __forceinline__ void operator()(const f32x4 (&acc)[2][2][4][2], const Unit& u, int wr, int wc, int fr, int fq) const {
        const int row0 = u.pm * BM + wr * 64 + fr; const int col0 = u.pn * HALF + wc * 32 + 8 * fq;
        float rsv[2][4];
#pragma unroll
        for (int ai = 0; ai < 2; ++ai)
#pragma unroll
            for (int m = 0; m < 4; ++m) rsv[ai][m] = HAS_RS ? rsl[(u.pm & 7) * 256 + wr * 64 + ai * HALF + m * 16 + fr] : 1.0f;
#pragma unroll
        for (int ai = 0; ai < 2; ++ai)
#pragma unroll
            for (int m = 0; m < 4; ++m) { bf16_t* rowp = O + (size_t)(row0 + ai * HALF + m * 16) * ldc + col0; const float rs = rsv[ai][m];
                float hv[8];
#pragma unroll
                for (int n = 0; n < 2; ++n)
#pragma unroll
                    for (int e = 0; e < 4; ++e) { const float g = acc[ai][0][m][n][e] * rs, up = acc[ai][1][m][n][e] * rs;
                        const float ex = __builtin_amdgcn_exp2f(-g * 1.4426950408889634f);
                        hv[n * 4 + e] = g * __builtin_amdgcn_rcpf(1.0f + ex) * up; }
                u32x4 w; w.x = cvt_pk_bf16(hv[0], hv[1]); w.y = cvt_pk_bf16(hv[2], hv[3]); w.z = cvt_pk_bf16(hv[4], hv[5]); w.w = cvt_pk_bf16(hv[6], hv[7]);
                *(u32x4*)rowp = w; }
    }
};
struct EpiBf16Rs {
    static constexpr bool PERM = true, AFTER_DRAIN = false;
    bf16_t* O; int ldc; PG8_LAS const float* rsl;
    __device__ __forceinline__ void operator()(const f32x4 (&acc)[2][2][4][2], const Unit& u, int wr, int wc, int fr, int fq) const {
        const int row0 = u.pm * BM + wr * 64 + fr; const int col0 = u.pn * BM + wc * 32 + 8 * fq;
        float rsv[2][4];
#pragma unroll
        for (int ai = 0; ai < 2; ++ai)
#pragma unroll
            for (int m = 0; m < 4; ++m) rsv[ai][m] = rsl[(u.pm & 7) * 256 + wr * 64 + ai * HALF + m * 16 + fr];
#pragma unroll
        for (int ai = 0; ai < 2; ++ai)
#pragma unroll
            for (int m = 0; m < 4; ++m) { bf16_t* rowp = O + (size_t)(row0 + ai * HALF + m * 16) * ldc + col0; const float rs = rsv[ai][m];
#pragma unroll
                for (int bj = 0; bj < 2; ++bj) { const f32x4 v0 = acc[ai][bj][m][0] * rs, v1 = acc[ai][bj][m][1] * rs;
                    u32x4 w; w.x = cvt_pk_bf16(v0[0], v0[1]); w.y = cvt_pk_bf16(v0[2], v0[3]); w.z = cvt_pk_bf16(v1[0], v1[1]); w.w = cvt_pk_bf16(v1[2], v1[3]);
                    *(u32x4*)(rowp + bj * HALF) = w; } }
    }
};
struct EpiQKV {
    static constexpr bool PERM = true, AFTER_DRAIN = false;
    bf16_t* O; PG8_LAS float* rsl; const float* qn; const float* kn;
    __device__ __forceinline__ void operator()(const f32x4 (&acc)[2][2][4][2], const Unit& u, int wr, int wc, int fr, int fq) const {
        constexpr int ldc = 6144; constexpr float QS = 0.08838834764831845f * 1.4426950408889634f;
        const int rl0 = wr * 64 + fr, row0 = u.pm * BM + rl0, col0 = u.pn * BM + wc * 32 + 8 * fq, lane = fr + 16 * fq;
        float rsv[2][4];
#pragma unroll
        for (int ai = 0; ai < 2; ++ai)
#pragma unroll
            for (int m = 0; m < 4; ++m) rsv[ai][m] = rsl[(u.pm & 7) * 256 + rl0 + ai * HALF + m * 16];
        if (u.pn >= 8) {
#pragma unroll
            for (int ai = 0; ai < 2; ++ai)
#pragma unroll
                for (int m = 0; m < 4; ++m) { bf16_t* rowp = O + (size_t)(row0 + ai * HALF + m * 16) * ldc + col0; const float rs = rsv[ai][m];
#pragma unroll
                    for (int bj = 0; bj < 2; ++bj) { const f32x4 v0 = acc[ai][bj][m][0] * rs, v1 = acc[ai][bj][m][1] * rs;
                        u32x4 w; w.x = cvt_pk_bf16(v0[0], v0[1]); w.y = cvt_pk_bf16(v0[2], v0[3]); w.z = cvt_pk_bf16(v1[0], v1[1]); w.w = cvt_pk_bf16(v1[2], v1[3]);
                        *(u32x4*)(rowp + bj * HALF) = w; } }
            return;
        }
        PG8_LAS float* xs = rsl + 2048;
#pragma unroll
        for (int ai = 0; ai < 2; ++ai)
#pragma unroll
            for (int m = 0; m < 4; ++m) { const float rs = rsv[ai][m];
#pragma unroll
                for (int bj = 0; bj < 2; ++bj) { const f32x4 v0 = acc[ai][bj][m][0] * rs, v1 = acc[ai][bj][m][1] * rs;
                    float sq = ((v0[0] * v0[0] + v0[1] * v0[1]) + (v0[2] * v0[2] + v0[3] * v0[3])) + ((v1[0] * v1[0] + v1[1] * v1[1]) + (v1[2] * v1[2] + v1[3] * v1[3]));
                    sq += __int_as_float(__builtin_amdgcn_ds_bpermute((lane ^ 16) << 2, __float_as_int(sq))); sq += __int_as_float(__builtin_amdgcn_ds_bpermute((lane ^ 32) << 2, __float_as_int(sq)));
                    if (fq == 0) xs[((rl0 + ai * HALF + m * 16) * 2 + bj) * 4 + wc] = sq; } }
        asm volatile("s_waitcnt lgkmcnt(0)" ::: "memory"); __builtin_amdgcn_s_barrier(); asm volatile("" ::: "memory");
        const bool isq = u.pn < 4;
        const float* gp = (isq ? qn : kn) + wc * 32 + 8 * fq;
        const f32x4 g0 = *(const f32x4*)gp, g1 = *(const f32x4*)(gp + 4);
        const float qs = isq ? QS : 1.0f, sgn = (fq < 2) ? -1.0f : 1.0f;
        float invf[8];
#pragma unroll
        for (int e = 0; e < 8; ++e) invf[e] = __builtin_amdgcn_exp2f(-(float)(8 * (fq & 1) + e) * (18.931568569324174f / 16.0f));
#pragma unroll
        for (int ai = 0; ai < 2; ++ai)
#pragma unroll
            for (int m = 0; m < 4; ++m) { const int rl = rl0 + ai * HALF + m * 16, row = u.pm * BM + rl; const float rs = rsv[ai][m];
                float cs[8], sn[8];
                if (wc == 0) { const float pos = (float)(row & 2047);
#pragma unroll
                    for (int e = 0; e < 8; ++e) { const float ang = pos * invf[e]; const float nr = __builtin_rintf(ang * 0.15915494309189535f);
                        float rr_ = __builtin_fmaf(-nr, 6.28318548202514648f, ang); rr_ = __builtin_fmaf(-nr, -1.74845553146951715e-7f, rr_); const float fr_ = rr_ * 0.15915494309189535f;
                        cs[e] = __builtin_amdgcn_cosf(fr_); sn[e] = __builtin_amdgcn_sinf(fr_); } }
#pragma unroll
                for (int bj = 0; bj < 2; ++bj) { const f32x4 pp = *(const PG8_LAS f32x4*)(xs + (rl * 2 + bj) * 4);
                    const float k = rs * qs / sqrtf(((pp[0] + pp[1]) + (pp[2] + pp[3])) * (1.0f / 128.0f) + 1e-5f);
                    float y[8];
#pragma unroll
                    for (int e = 0; e < 8; ++e) y[e] = acc[ai][bj][m][e >> 2][e & 3] * (e < 4 ? g0[e] : g1[e - 4]);
                    if (wc == 0) {
#pragma unroll
                        for (int e = 0; e < 8; ++e) { auto rr = __builtin_amdgcn_permlane32_swap(__float_as_uint(y[e]), __float_as_uint(y[e]), false, false);
                            const float yp = __uint_as_float((fq >> 1) ? rr[0] : rr[1]); y[e] = y[e] * cs[e] + sgn * yp * sn[e]; } }
                    u32x4 w; w.x = cvt_pk_bf16(y[0] * k, y[1] * k); w.y = cvt_pk_bf16(y[2] * k, y[3] * k); w.z = cvt_pk_bf16(y[4] * k, y[5] * k); w.w = cvt_pk_bf16(y[6] * k, y[7] * k);
                    *(u32x4*)(O + (size_t)row * ldc + col0 + bj * HALF) = w; } }
    }
};
template <bool BASE_BF16, int ALPHA_X2, size_t SS_OFF> struct EpiResidB {
    static constexpr bool PERM = true, AFTER_DRAIN = false;
    const void* base; bf16_t* out; int ldc; unsigned char* wsb;
    __device__ __forceinline__ void operator()(const f32x4 (&acc)[2][2][4][2], const Unit& u, int wr, int wc, int fr, int fq) const {
        const int row0 = u.pm * BM + wr * 64 + fr; const int col0 = u.pn * BM + wc * 32 + 8 * fq; const int lane = fr + 16 * fq; constexpr float alpha = 0.5f * ALPHA_X2;
        float* ssp = (float*)(wsb + SS_OFF);
#pragma unroll
        for (int ai = 0; ai < 2; ++ai) {
            u32x4 bb[4][2]; f32x4 bf[4][2][2];
#pragma unroll
            for (int m = 0; m < 4; ++m) { const size_t ro = (size_t)(row0 + ai * HALF + m * 16) * ldc + col0;
#pragma unroll
                for (int bj = 0; bj < 2; ++bj) {
                    if (BASE_BF16) bb[m][bj] = *(const u32x4*)((const bf16_t*)base + ro + bj * HALF);
                    else { bf[m][bj][0] = *(const f32x4*)((const float*)base + ro + bj * HALF); bf[m][bj][1] = *(const f32x4*)((const float*)base + ro + bj * HALF + 4); } } }
            asm volatile("" ::: "memory");
#pragma unroll
            for (int m = 0; m < 4; ++m) { const int row = row0 + ai * HALF + m * 16; const size_t ro = (size_t)row * ldc + col0; float sq = 0.f;
#pragma unroll
                for (int bj = 0; bj < 2; ++bj) { f32x4 b0, b1;
                    if (BASE_BF16) { const u32x4 w = bb[m][bj]; b0 = (f32x4){bflo(w.x), bfhi(w.x), bflo(w.y), bfhi(w.y)}; b1 = (f32x4){bflo(w.z), bfhi(w.z), bflo(w.w), bfhi(w.w)}; }
                    else { b0 = bf[m][bj][0]; b1 = bf[m][bj][1]; }
                    const f32x4 v0 = b0 + acc[ai][bj][m][0] * alpha, v1 = b1 + acc[ai][bj][m][1] * alpha;
                    sq += ((v0[0] * v0[0] + v0[1] * v0[1]) + (v0[2] * v0[2] + v0[3] * v0[3])) + ((v1[0] * v1[0] + v1[1] * v1[1]) + (v1[2] * v1[2] + v1[3] * v1[3]));
                    u32x4 o; o.x = cvt_pk_bf16(v0[0], v0[1]); o.y = cvt_pk_bf16(v0[2], v0[3]); o.z = cvt_pk_bf16(v1[0], v1[1]); o.w = cvt_pk_bf16(v1[2], v1[3]);
                    *(u32x4*)(out + ro + bj * HALF) = o; }
                sq += __int_as_float(__builtin_amdgcn_ds_bpermute((lane ^ 16) << 2, __float_as_int(sq))); sq += __int_as_float(__builtin_amdgcn_ds_bpermute((lane ^ 32) << 2, __float_as_int(sq)));
                if (fq == 0) ssp[(size_t)row * 32 + u.pn * 4 + wc] = sq; }
            asm volatile("" ::: "memory");
        }
    }
};
}

namespace cg = cooperative_groups;
#define LAS __attribute__((address_space(3)))
#define DI __device__ __forceinline__
typedef unsigned short bf16_t;
typedef short bf16x8 __attribute__((ext_vector_type(8)));
typedef short s16x4 __attribute__((ext_vector_type(4)));
typedef float f32x4 __attribute__((ext_vector_type(4)));
typedef float f32x2 __attribute__((ext_vector_type(2)));
typedef float f32x16 __attribute__((ext_vector_type(16)));
typedef unsigned u32x4 __attribute__((ext_vector_type(4)));
typedef unsigned u32x2 __attribute__((ext_vector_type(2)));
typedef __bf16 bf16x2_t __attribute__((ext_vector_type(2)));

constexpr int BATCH = 8, SEQ = 2048, DM = 2048, DFF = 5632, INC = 6144, M = BATCH * SEQ;
constexpr float EPS = 1e-5f;
constexpr float LOG2E = 1.4426950408889634f;
constexpr float QSCALE = 0.08838834764831845f * LOG2E;
constexpr int NWAVES = 8, NTHREADS = 512;

constexpr size_t MiB = 1u << 20;
constexpr size_t WS_CTL = 0;
constexpr size_t WS_WGU1 = 1 * MiB, WS_WD1 = 45 * MiB, WS_WIN = 67 * MiB, WS_WOUT = 91 * MiB, WS_WGU2 = 99 * MiB, WS_WD2 = 143 * MiB;
constexpr size_t WS_XN = 166 * MiB;
constexpr size_t WS_BIG = 230 * MiB;
constexpr size_t WS_SSP = 422 * MiB;
constexpr size_t WS_END = 428 * MiB;
constexpr int RING_BYTES = 131072, MISC_OFF = RING_BYTES, LDS_BYTES = RING_BYTES + 1024 + 8192 + 8192;

DI unsigned cvtpk(float lo, float hi) { f32x2 v = {lo, hi}; bf16x2_t b = __builtin_convertvector(v, bf16x2_t); return __builtin_bit_cast(unsigned, b); }
DI float bf2f(unsigned short s) { return __uint_as_float((unsigned)s << 16); }
DI float shx(float v, int o, int lane) { return __int_as_float(__builtin_amdgcn_ds_bpermute((lane ^ o) << 2, __float_as_int(v))); }
DI float swap32(float v, int h) { auto rr = __builtin_amdgcn_permlane32_swap(__float_as_uint(v), __float_as_uint(v), false, false); return __uint_as_float(h ? rr[0] : rr[1]); }
DI float wave_sum(float v, int lane) {
#pragma unroll
    for (int o = 1; o < 64; o <<= 1) v += shx(v, o, lane);
    return v;
}
DI void block_sync() { asm volatile("s_waitcnt vmcnt(0) lgkmcnt(0)" ::: "memory"); __builtin_amdgcn_s_barrier(); asm volatile("" ::: "memory"); }

template <bool HAS_GAIN> DI void transpose_item(const float* __restrict__ W, int K, int N, bf16_t* __restrict__ WT, int mode, int slo, int shi, float scale, const float* __restrict__ kgain, LAS float* scr, int item, int lane) {
    asm volatile("" : "+v"(lane));
    const int nblk = N / 32, kb = item / nblk, nb = item % nblk, k0 = 64 * kb, n0 = 32 * nb;
    float gvec = 1.0f; if (HAS_GAIN) gvec = kgain[k0 + lane];
#pragma unroll 8
    for (int i = 0; i < 32; ++i) { const int kk = 2 * i + (lane >> 5); float wv = W[(size_t)(k0 + kk) * N + n0 + (lane & 31)];
        if (HAS_GAIN) { const float g0 = __uint_as_float(__builtin_amdgcn_readlane(__float_as_uint(gvec), 2 * i)), g1 = __uint_as_float(__builtin_amdgcn_readlane(__float_as_uint(gvec), 2 * i + 1)); wv *= (lane >> 5) ? g1 : g0; }
        scr[kk * 33 + (lane & 31)] = wv; }
    asm volatile("s_waitcnt lgkmcnt(0)" ::: "memory");
    const int c = lane & 7;
    const float sc = (n0 >= slo && n0 < shi) ? scale : 1.0f;
    const int rbase = mode == 0 ? n0 : ((n0 >> 7) * 256 + (n0 & 127) + (mode == 2 ? 128 : 0));
#pragma unroll
    for (int j = 0; j < 4; ++j) { const int n = (lane >> 3) + 8 * j; const LAS float* s = scr + (8 * c) * 33 + n;
        u32x4 o; o.x = cvtpk(s[0 * 33] * sc, s[1 * 33] * sc); o.y = cvtpk(s[2 * 33] * sc, s[3 * 33] * sc); o.z = cvtpk(s[4 * 33] * sc, s[5 * 33] * sc); o.w = cvtpk(s[6 * 33] * sc, s[7 * 33] * sc);
        *(u32x4*)(WT + (size_t)(rbase + n) * K + k0 + 8 * c) = o; }
    asm volatile("s_waitcnt lgkmcnt(0)" ::: "memory");
}

template <bool F32OUT> DI void rms_rows(const float* src, const float* __restrict__ gain, bf16_t* dstb, float* dstf, int gw, int NGW, int lane) {
    asm volatile("" : "+v"(lane));
    for (int m = gw; m < M; m += NGW) {
        const f32x4* xr = (const f32x4*)(src + (size_t)m * DM) + lane;
        f32x4 v[8]; float s = 0.f;
#pragma unroll
        for (int j = 0; j < 8; ++j) { v[j] = xr[64 * j]; s += (v[j].x * v[j].x + v[j].y * v[j].y) + (v[j].z * v[j].z + v[j].w * v[j].w); }
        const float rstd = 1.0f / sqrtf(wave_sum(s, lane) * (1.0f / DM) + EPS);
#pragma unroll
        for (int j = 0; j < 8; ++j) { const f32x4 g = ((const f32x4*)gain)[lane + 64 * j]; const f32x4 y = v[j] * rstd * g;
            if (F32OUT) ((f32x4*)(dstf + (size_t)m * DM))[lane + 64 * j] = y;
            else { u32x2 w; w.x = cvtpk(y.x, y.y); w.y = cvtpk(y.z, y.w); ((u32x2*)(dstb + (size_t)m * DM))[lane + 64 * j] = w; } }
    }
}

DI void build_rs(LAS float* rsl, const float* __restrict__ ssp, int fm, int wid, int lane) {
    asm volatile("" : "+v"(lane));
#pragma unroll 2
    for (int k = 0; k < 8; ++k) { const int rl = wid * 32 + (lane >> 1); const f32x4* p = (const f32x4*)(ssp + ((size_t)(fm + k) * 256 + rl) * 32 + (lane & 1) * 16);
        const f32x4 a = p[0], b = p[1], c = p[2], d = p[3]; float sm = ((a.x + a.y) + (a.z + a.w)) + ((b.x + b.y) + (b.z + b.w)) + ((c.x + c.y) + (c.z + c.w)) + ((d.x + d.y) + (d.z + d.w));
        sm += shx(sm, 1, lane);
        if ((lane & 1) == 0) rsl[k * 256 + rl] = 1.0f / sqrtf(sm * (1.0f / DM) + EPS); }
    block_sync();
}
DI void final_rows(float* __restrict__ out, const bf16_t* __restrict__ xb, const float* __restrict__ ssp, const float* __restrict__ gain, int gw, int NGW, int lane) {
    asm volatile("" : "+v"(lane));
    for (int m = gw; m < M; m += NGW) {
        const u32x4* xr = (const u32x4*)(xb + (size_t)m * DM) + lane;
        u32x4 raw[4];
#pragma unroll
        for (int j = 0; j < 4; ++j) raw[j] = xr[64 * j];
        const float rstd = 1.0f / sqrtf(wave_sum(lane < 32 ? ssp[(size_t)m * 32 + lane] : 0.f, lane) * (1.0f / DM) + EPS);
        f32x4* orow = (f32x4*)(out + (size_t)m * DM);
#pragma unroll
        for (int j = 0; j < 4; ++j) { const int c8 = lane + 64 * j; const f32x4 g0 = ((const f32x4*)gain)[2 * c8], g1 = ((const f32x4*)gain)[2 * c8 + 1]; const u32x4 w = raw[j];
            f32x4 y0 = {__uint_as_float(w.x << 16), __uint_as_float(w.x & 0xffff0000u), __uint_as_float(w.y << 16), __uint_as_float(w.y & 0xffff0000u)};
            f32x4 y1 = {__uint_as_float(w.z << 16), __uint_as_float(w.z & 0xffff0000u), __uint_as_float(w.w << 16), __uint_as_float(w.w & 0xffff0000u)};
            orow[2 * c8] = y0 * rstd * g0; orow[2 * c8 + 1] = y1 * rstd * g1; }
    }
}

DI void qknorm_rows(bf16_t* U, const float* __restrict__ qn, const float* __restrict__ kn, int gw, int NGW, int lane) {
    asm volatile("" : "+v"(lane));
    const int cw = lane & 15;
    for (int m = gw; m < M; m += NGW) {
        const int pos = m & (SEQ - 1);
        float cs[8], sn[8];
        if (cw < 4) {
#pragma unroll
            for (int e = 0; e < 8; ++e) { const int fi = 8 * (cw & 1) + e;
                const float invf = exp2f(-(float)fi * (18.931568569324174f / 16.0f));
                const float ang = (float)pos * invf;
                double rv = (double)ang * 0.15915494309189535; rv -= __builtin_rint(rv); const float fr = (float)rv;
                cs[e] = __builtin_amdgcn_cosf(fr); sn[e] = __builtin_amdgcn_sinf(fr); }
        } else {
#pragma unroll
            for (int e = 0; e < 8; ++e) { cs[e] = 1.f; sn[e] = 0.f; }
        }
        bf16_t* urow = U + (size_t)m * INC;
        u32x4 raws[4];
#pragma unroll
        for (int j = 0; j < 4; ++j) raws[j] = ((const u32x4*)urow)[lane + 64 * j];
#pragma unroll
        for (int j = 0; j < 4; ++j) {
            const u32x4 raw = raws[j];
            float v[8];
#pragma unroll
            for (int e = 0; e < 4; ++e) { v[2 * e] = __uint_as_float(raw[e] << 16); v[2 * e + 1] = __uint_as_float(raw[e] & 0xffff0000u); }
            float ss = 0.f;
#pragma unroll
            for (int e = 0; e < 8; ++e) ss += v[e] * v[e];
            ss += shx(ss, 1, lane); ss += shx(ss, 2, lane); ss += shx(ss, 4, lane); ss += shx(ss, 8, lane);
            const float rstd = 1.0f / sqrtf(ss * (1.0f / 128.0f) + EPS);
            const float* gp = (j < 2 ? qn : kn) + 8 * cw;
            const f32x4 g0 = *(const f32x4*)gp, g1 = *(const f32x4*)(gp + 4);
            float y[8];
#pragma unroll
            for (int e = 0; e < 8; ++e) y[e] = v[e] * rstd * (e < 4 ? g0[e] : g1[e - 4]);
            const float sgn = (cw < 2) ? -1.f : 1.f;
#pragma unroll
            for (int e = 0; e < 8; ++e) { const float yp = shx(y[e], 2, lane); y[e] = y[e] * cs[e] + sgn * yp * sn[e]; }
            if (j < 2) {
#pragma unroll
                for (int e = 0; e < 8; ++e) y[e] *= QSCALE;
            }
            u32x4 w; w.x = cvtpk(y[0], y[1]); w.y = cvtpk(y[2], y[3]); w.z = cvtpk(y[4], y[5]); w.w = cvtpk(y[6], y[7]);
            ((u32x4*)urow)[lane + 64 * j] = w;
        }
    }
}

namespace att {
constexpr int ULD = INC, STAGE = 65536;
constexpr float NEG = -1e30f;
DI int crow(int i, int h) { return (i & 3) + 8 * (i >> 2) + 4 * h; }
DI void glds16(const void* g, LAS unsigned char* l) { __builtin_amdgcn_global_load_lds((const unsigned*)g, (LAS unsigned*)l, 16, 0, 0); }
template <int MODE> DI void load_tile128(const bf16_t* g, LAS unsigned char* dst, int wid, int lane) {
#pragma unroll
    for (int t = 0; t < 2; ++t) { const int ci = wid + 8 * t, R = 4 * ci + (lane >> 4), cp = lane & 15;
        const int c = MODE == 0 ? (cp ^ (R & 15)) : ((((cp >> 2) ^ (R & 3)) << 2) | (cp & 3));
        glds16(g + (size_t)R * ULD + c * 8, dst + ci * 1024); }
}
DI void load_tile256(const bf16_t* g, LAS unsigned char* dst, int wid, int lane) {
#pragma unroll
    for (int t = 0; t < 4; ++t) { const int ci = wid + 8 * t, R = 2 * ci + (lane >> 5), cp = lane & 31;
        const int c = (((cp >> 2) ^ (R & 3)) << 2) | (cp & 3);
        glds16(g + (size_t)R * ULD + c * 8, dst + ci * 1024); }
}
DI s16x4 vtr(const LAS unsigned char* p) { typedef short v4i16_t __attribute__((ext_vector_type(4))); return __builtin_bit_cast(s16x4, __builtin_amdgcn_ds_read_tr16_b64_v4i16((LAS v4i16_t*)p)); }
DI bf16x8 pack8(const f32x16& x, int s) {
    u32x4 p; p.x = cvtpk(x[8 * s], x[8 * s + 1]); p.y = cvtpk(x[8 * s + 2], x[8 * s + 3]); p.z = cvtpk(x[8 * s + 4], x[8 * s + 5]); p.w = cvtpk(x[8 * s + 6], x[8 * s + 7]);
    return __builtin_bit_cast(bf16x8, p);
}
#define MFMA32(a, b, c) __builtin_amdgcn_mfma_f32_32x32x16_bf16((a), (b), (c), 0, 0, 0)
DI void qk_tile(f32x16 (&sT)[2], const LAS unsigned char* kimg, const bf16x8 (&qf)[8], int r, int h) {
    const LAS unsigned char* kp = kimg + r * 256; const int sw = r & 15;
    bf16x8 kf[2][2][2];
#define QK_LOAD(bt) do { _Pragma("unroll") for (int s2 = 0; s2 < 2; ++s2) _Pragma("unroll") for (int kb = 0; kb < 2; ++kb) \
        kf[(bt) & 1][s2][kb] = *(const LAS bf16x8*)(kp + kb * 8192 + (((2 * (2 * (bt) + s2) + h) ^ sw) << 4)); } while (0)
    QK_LOAD(0);
    f32x16 a0 = {}, a1 = {};
#pragma unroll
    for (int bt = 0; bt < 4; ++bt) {
        if (bt + 1 < 4) QK_LOAD(bt + 1);
        __builtin_amdgcn_sched_barrier(0);
#pragma unroll
        for (int s2 = 0; s2 < 2; ++s2) { a0 = MFMA32(kf[bt & 1][s2][0], qf[2 * bt + s2], a0); a1 = MFMA32(kf[bt & 1][s2][1], qf[2 * bt + s2], a1); }
        __builtin_amdgcn_sched_barrier(0);
    }
#undef QK_LOAD
    sT[0] = a0; sT[1] = a1;
}
DI f32x16 qk_half_lq(const LAS unsigned char* kimg32, const LAS unsigned char* qimg, int r, int h) {
    const int sw = r & 15; const LAS unsigned char* kp = kimg32 + r * 256; const LAS unsigned char* qp = qimg + r * 256;
    bf16x8 kf[2][2], qv[2][2];
#define QK_LOAD(bt) do { _Pragma("unroll") for (int s2 = 0; s2 < 2; ++s2) { const int co = (((2 * (2 * (bt) + s2) + h) ^ sw) << 4); qv[(bt) & 1][s2] = *(const LAS bf16x8*)(qp + co); \
        kf[(bt) & 1][s2] = *(const LAS bf16x8*)(kp + co); } } while (0)
    QK_LOAD(0);
    f32x16 a0 = {};
#pragma unroll
    for (int bt = 0; bt < 4; ++bt) {
        if (bt + 1 < 4) QK_LOAD(bt + 1);
        __builtin_amdgcn_sched_barrier(0);
#pragma unroll
        for (int s2 = 0; s2 < 2; ++s2) a0 = MFMA32(kf[bt & 1][s2], qv[bt & 1][s2], a0);
        __builtin_amdgcn_sched_barrier(0);
    }
#undef QK_LOAD
    return a0;
}
template <int RB> DI void pv_half(f32x16 (&o)[4], const f32x16& x, const LAS unsigned char* vimg, int lane, int kb) {
    const int h = lane >> 5, half = (lane >> 4) & 1, q = (lane & 15) >> 2, p = lane & 3;
    const LAS unsigned char* vb = vimg + (32 * kb + 4 * h + q) * RB + 32 * half + 8 * p;
    s16x4 lo[2][4], hi[2][4];
#pragma unroll
    for (int db = 0; db < 4; ++db) { const LAS unsigned char* a = vb + ((db ^ q) << 6); lo[0][db] = vtr(a); hi[0][db] = vtr(a + 8 * RB); }
#pragma unroll
    for (int s = 0; s < 2; ++s) {
        const bf16x8 pf = pack8(x, s);
        if (s == 0) {
#pragma unroll
            for (int db = 0; db < 4; ++db) { const LAS unsigned char* a = vb + ((db ^ q) << 6) + 16 * RB; lo[1][db] = vtr(a); hi[1][db] = vtr(a + 8 * RB); }
        }
        __builtin_amdgcn_sched_barrier(0);
#pragma unroll
        for (int db = 0; db < 4; ++db) { const bf16x8 vf = __builtin_shufflevector(lo[s][db], hi[s][db], 0, 1, 2, 3, 4, 5, 6, 7); o[db] = MFMA32(vf, pf, o[db]); }
        __builtin_amdgcn_sched_barrier(0);
    }
}
template <int RB> DI void pv_tile(f32x16 (&o)[4], const f32x16 (&sT)[2], const LAS unsigned char* vimg, int lane, int db0) {
    const int h = lane >> 5, half = (lane >> 4) & 1, q = (lane & 15) >> 2, p = lane & 3;
    const LAS unsigned char* vb = vimg + (4 * h + q) * RB + 32 * half + 8 * p;
    const LAS unsigned char* va[4];
#pragma unroll
    for (int db = 0; db < 4; ++db) va[db] = vb + (((db0 + db) ^ q) << 6);
    s16x4 lo[2][4], hi[2][4];
#pragma unroll
    for (int db = 0; db < 4; ++db) { lo[0][db] = vtr(va[db]); hi[0][db] = vtr(va[db] + 8 * RB); }
#pragma unroll
    for (int s = 0; s < 4; ++s) {
        const bf16x8 pf = pack8(sT[s >> 1], s & 1);
        if (s + 1 < 4) {
#pragma unroll
            for (int db = 0; db < 4; ++db) { lo[(s + 1) & 1][db] = vtr(va[db] + 16 * (s + 1) * RB); hi[(s + 1) & 1][db] = vtr(va[db] + 16 * (s + 1) * RB + 8 * RB); }
        }
        __builtin_amdgcn_sched_barrier(0);
#pragma unroll
        for (int db = 0; db < 4; ++db) { const bf16x8 vf = __builtin_shufflevector(lo[s & 1][db], hi[s & 1][db], 0, 1, 2, 3, 4, 5, 6, 7); o[db] = MFMA32(vf, pf, o[db]); }
        __builtin_amdgcn_sched_barrier(0);
    }
}

DI f32x16 qk_half(const LAS unsigned char* kimg32, const bf16x8 (&qf)[8], int r, int h) {
    const int sw = r & 15; const LAS unsigned char* kp = kimg32 + r * 256;
    bf16x8 kf[8];
#pragma unroll
    for (int s = 0; s < 8; ++s) kf[s] = *(const LAS bf16x8*)(kp + (((2 * s + h) ^ sw) << 4));
    f32x16 a0 = {};
#pragma unroll
    for (int s = 0; s < 8; ++s) a0 = MFMA32(kf[s], qf[s], a0);
    return a0;
}
DI void diff_unit(int bh, int qb, const bf16_t* __restrict__ U, bf16_t* __restrict__ AO, const float* __restrict__ subln, float lam, LAS unsigned char* lds, int wid, int lane) {
    asm volatile("" : "+v"(lane));
    const int b = bh >> 2, hd = bh & 3, r = lane & 31, h = lane >> 5, pi = wid >> 2, map = (wid >> 1) & 1, dh = wid & 1;
    const int q0w = qb * 64 + 32 * pi;
    const size_t rowbase = (size_t)b * SEQ;
    bf16x8 qf[8];
    { const bf16_t* Qp = U + (rowbase + q0w + r) * ULD + map * 512 + hd * 128 + h * 8;
#pragma unroll
      for (int s = 0; s < 8; ++s) qf[s] = *(const bf16x8*)(Qp + 16 * s); }
    const int NB = 2 * qb + 2, mynb = 2 * qb + pi + 1;
    const bf16_t* Kg1 = U + rowbase * ULD + 1024 + hd * 128;
    const bf16_t* Vg = U + rowbase * ULD + 2048 + hd * 256;
    unsigned offK, offV0, offV1;
    { const int R = 4 * wid + (lane >> 4), cp = lane & 15; offK = (unsigned)(R * ULD + ((cp ^ (R & 15)) << 3)); }
    { const int cp = lane & 31; const int R0 = 2 * wid + (lane >> 5), R1 = R0 + 16;
      offV0 = (unsigned)(R0 * ULD + (((((cp >> 2) ^ (R0 & 3)) << 2) | (cp & 3)) << 3)); offV1 = (unsigned)(R1 * ULD + (((((cp >> 2) ^ (R1 & 3)) << 2) | (cp & 3)) << 3)); }
#define DIFF_PIECE(j, p) do { const int jj_ = (j) < 63 ? (j) : 63; const size_t ko = (size_t)(32 * jj_) * ULD; LAS unsigned char* sp_ = lds + ((j) & 3) * 32768 + wid * 1024; \
        if ((p) == 0) glds16(Kg1 + ko + offK, sp_); else if ((p) == 1) glds16(Kg1 + 512 + ko + offK, sp_ + 8192); else if ((p) == 2) glds16(Vg + ko + offV0, sp_ + 16384); else glds16(Vg + ko + offV1, sp_ + 24576); } while (0)
#define DIFF_ISSUE(j) do { DIFF_PIECE(j, 0); DIFF_PIECE(j, 1); DIFF_PIECE(j, 2); DIFF_PIECE(j, 3); } while (0)
#define DIFF_SYNC() asm volatile("s_waitcnt vmcnt(4) lgkmcnt(0)\n\ts_barrier" ::: "memory")
    f32x16 o[4];
#pragma unroll
    for (int d = 0; d < 4; ++d) o[d] = (f32x16){};
    float mrun = NEG, lrun = 0.f;
    DIFF_ISSUE(0); DIFF_ISSUE(1); DIFF_ISSUE(2);
    asm volatile("s_waitcnt vmcnt(0) lgkmcnt(0)\n\ts_barrier" ::: "memory");
    f32x16 scur = qk_half(lds + map * 8192, qf, r, h);
    const int hq = lane >> 5, half = (lane >> 4) & 1, vq = (lane & 15) >> 2, vp = lane & 3;
    const int voff = 16384 + (4 * hq + vq) * 512 + 32 * half + 8 * vp;
    const int ksw = r & 15;
    constexpr float DIFF_THR = 8.0f;
#define DIFF_MAX() do { float mx = scur[0]; _Pragma("unroll") for (int i = 1; i < 16; ++i) mx = fmaxf(mx, scur[i]); mx = fmaxf(mx, swap32(mx, h)); const float mnew = fmaxf(mrun, mx); \
        if (__any(mnew > mrun + DIFF_THR)) { const float f = __builtin_amdgcn_exp2f(mrun - mnew); lrun *= f; _Pragma("unroll") for (int d = 0; d < 4; ++d) o[d] = o[d] * f; mrun = mnew; } } while (0)
#define DIFF_VREAD(j) do { const LAS unsigned char* vb = lds + ((j) & 3) * 32768 + voff; _Pragma("unroll") for (int s_ = 0; s_ < 2; ++s_) _Pragma("unroll") for (int db = 0; db < 4; ++db) { \
        const LAS unsigned char* a_ = vb + 16 * s_ * 512 + (((4 * dh + db) ^ vq) << 6); lo[s_][db] = vtr(a_); hi[s_][db] = vtr(a_ + 8 * 512); } } while (0)
#define DIFF_PV() do { _Pragma("unroll") for (int s_ = 0; s_ < 2; ++s_) { const bf16x8 pf = pack8(scur, s_); _Pragma("unroll") for (int db = 0; db < 4; ++db) { \
        const bf16x8 vf = __builtin_shufflevector(lo[s_][db], hi[s_][db], 0, 1, 2, 3, 4, 5, 6, 7); o[db] = MFMA32(vf, pf, o[db]); } } } while (0)
    int j = 0;
    for (; j < mynb - 1; ++j) {
        DIFF_MAX();
        DIFF_SYNC();
        bf16x8 kf[8]; s16x4 lo[2][4], hi[2][4];
        { const LAS unsigned char* kp = lds + ((j + 1) & 3) * 32768 + map * 8192 + r * 256;
#pragma unroll
          for (int s = 0; s < 8; ++s) kf[s] = *(const LAS bf16x8*)(kp + (((2 * s + h) ^ ksw) << 4)); }
        __builtin_amdgcn_sched_barrier(0);
        f32x16 sn = {}; float ps = 0.f;
        const LAS unsigned char* vbj = lds + (j & 3) * 32768 + voff;
#pragma unroll
        for (int s = 0; s < 8; ++s) {
            sn = MFMA32(kf[s], qf[s], sn);
            if (s < 4) {
#pragma unroll
                for (int s_ = 0; s_ < 2; ++s_) { const LAS unsigned char* a_ = vbj + 16 * s_ * 512 + (((4 * dh + s) ^ vq) << 6); lo[s_][s] = vtr(a_); hi[s_][s] = vtr(a_ + 8 * 512); }
            }
            if ((s & 1) == 0) DIFF_PIECE(j + 3, s >> 1);
            const float e0 = __builtin_amdgcn_exp2f(scur[s] - mrun);
            scur[s] = e0; ps += e0;
            __builtin_amdgcn_sched_barrier(0);
        }
        {
            const bf16x8 pf0 = pack8(scur, 0);
#pragma unroll
            for (int db = 0; db < 4; ++db) { const bf16x8 vf = __builtin_shufflevector(lo[0][db], hi[0][db], 0, 1, 2, 3, 4, 5, 6, 7); o[db] = MFMA32(vf, pf0, o[db]);
                const float e0 = __builtin_amdgcn_exp2f(scur[8 + 2 * db] - mrun), e1 = __builtin_amdgcn_exp2f(scur[9 + 2 * db] - mrun);
                scur[8 + 2 * db] = e0; scur[9 + 2 * db] = e1; ps += e0 + e1;
                __builtin_amdgcn_sched_barrier(0); }
            const bf16x8 pf1 = pack8(scur, 1);
#pragma unroll
            for (int db = 0; db < 4; ++db) { const bf16x8 vf = __builtin_shufflevector(lo[1][db], hi[1][db], 0, 1, 2, 3, 4, 5, 6, 7); o[db] = MFMA32(vf, pf1, o[db]); }
        }
        lrun += ps;
        scur = sn;
    }
    {
#pragma unroll
        for (int i = 0; i < 16; ++i) if (crow(i, h) > r) scur[i] = NEG;
        DIFF_MAX();
        DIFF_SYNC();
        DIFF_ISSUE(j + 3);
        s16x4 lo[2][4], hi[2][4];
        DIFF_VREAD(j);
        float ps = 0.f;
#pragma unroll
        for (int i = 0; i < 16; ++i) { const float pe = __builtin_amdgcn_exp2f(scur[i] - mrun); scur[i] = pe; ps += pe; }
        lrun += ps;
        DIFF_PV();
        ++j;
    }
    for (; j < NB; ++j) { DIFF_SYNC(); DIFF_ISSUE(j + 3); }
#undef DIFF_MAX
#undef DIFF_VREAD
#undef DIFF_PV
#undef DIFF_SYNC
#undef DIFF_PIECE
#undef DIFF_ISSUE
    block_sync();
    const float ltot = lrun + swap32(lrun, h);
    LAS float* comb = (LAS float*)(lds + (pi * 2 + dh) * 16384) + lane;
    LAS float* ssb = (LAS float*)(lds + 65536);
    if (map == 1) {
        const float sc = lam / ltot;
#pragma unroll
        for (int d = 0; d < 4; ++d)
#pragma unroll
            for (int i = 0; i < 16; ++i) comb[(d * 16 + i) * 64] = o[d][i] * sc;
    }
    block_sync();
    if (map == 0) {
        const float sc = 1.0f / ltot; float ss = 0.f;
#pragma unroll
        for (int d = 0; d < 4; ++d)
#pragma unroll
            for (int i = 0; i < 16; ++i) { const float v = o[d][i] * sc - comb[(d * 16 + i) * 64]; o[d][i] = v; ss += v * v; }
        ss += swap32(ss, h);
        if (h == 0) ssb[(pi * 2 + dh) * 32 + r] = ss;
    }
    block_sync();
    if (map == 0) {
        const float ss = ssb[(pi * 2) * 32 + r] + ssb[(pi * 2 + 1) * 32 + r];
        const float rstd = 0.8f / sqrtf(ss * (1.0f / 256.0f) + EPS);
        bf16_t* orow = AO + (rowbase + q0w + r) * DM + hd * 256 + dh * 128 + 4 * h;
        const float* gp = subln + dh * 128 + 4 * h;
#pragma unroll
        for (int d = 0; d < 4; ++d)
#pragma unroll
            for (int g = 0; g < 4; ++g) { const f32x4 gv = *(const f32x4*)(gp + 32 * d + 8 * g);
                u32x2 w; w.x = cvtpk(o[d][4 * g] * rstd * gv.x, o[d][4 * g + 1] * rstd * gv.y); w.y = cvtpk(o[d][4 * g + 2] * rstd * gv.z, o[d][4 * g + 3] * rstd * gv.w);
                *(u32x2*)(orow + 32 * d + 8 * g) = w; }
    }
    block_sync();
}

template <bool MASKED> DI void sb_weights(f32x16& x, float& base, int kbase  , int qg, int h) {
    float L[16];
#pragma unroll
    for (int i = 0; i < 16; ++i) { const float z = x[i]; const float e = __builtin_amdgcn_exp2f(-fabsf(z));
        float l2 = -(fmaxf(z, 0.f) + __builtin_amdgcn_logf(1.0f + e));
        if (MASKED) { const int kg = kbase + crow(i, h); if (!(kg < qg)) l2 = 0.f; }
        L[i] = l2; if ((i & 7) == 7) __builtin_amdgcn_sched_barrier(0); }
    float T[4], To[4];
#pragma unroll
    for (int g = 0; g < 4; ++g) { L[4 * g + 2] += L[4 * g + 3]; L[4 * g + 1] += L[4 * g + 2]; L[4 * g] += L[4 * g + 1]; T[g] = L[4 * g]; To[g] = swap32(T[g], h); }
    float off[4]; float suf = 0.f;
#pragma unroll
    for (int g = 3; g >= 0; --g) { off[g] = suf + (h == 0 ? To[g] : 0.f); suf += T[g] + To[g]; }
#pragma unroll
    for (int i = 0; i < 16; ++i) { const float c = L[i] + off[i >> 2] + base; float a = __builtin_amdgcn_exp2f(x[i] + c);
        if (MASKED) { const int kg = kbase + crow(i, h); if (!(kg < qg)) a = 0.f; }
        x[i] = a; if ((i & 7) == 7) __builtin_amdgcn_sched_barrier(0); }
    base += suf;
}
constexpr float SB_CUT = 48.0f;
DI void sb_unit(int bh, int qb, const bf16_t* __restrict__ U, bf16_t* __restrict__ AO, LAS unsigned char* lds, int wid, int lane) {
    asm volatile("" : "+v"(lane));
    const int b = bh >> 3, hd = bh & 7, r = lane & 31, h = lane >> 5;
    const int q0w = qb * 256 + 32 * wid;
    const size_t rowbase = (size_t)b * SEQ;
    LAS unsigned char* qimg = lds + (wid < 4 ? 32768 + wid * 8192 : 98304 + (wid - 4) * 8192);
    { const bf16_t* Qp = U + (rowbase + q0w) * ULD + 3072 + hd * 128;
#pragma unroll
      for (int t = 0; t < 8; ++t) { const int Rr = 4 * t + (lane >> 4), cp = lane & 15; glds16(Qp + (size_t)Rr * ULD + ((cp ^ (Rr & 15)) << 3), qimg + t * 1024); } }
    const bf16_t* Kg = U + rowbase * ULD + 4096 + hd * 128;
    const bf16_t* Vg = U + rowbase * ULD + 5120 + hd * 128;
    const int NT = 4 * qb + 4;
    volatile LAS int* flags = (volatile LAS int*)(lds + MISC_OFF + 64);
    f32x16 o[4];
#pragma unroll
    for (int d = 0; d < 4; ++d) o[d] = (f32x16){};
    float R = 0.f;
#define SB_ISSUE(kt, st) do { const size_t ko = (size_t)(64 * (kt)) * ULD; LAS unsigned char* sp = lds + (st) * STAGE; \
        load_tile128<0>(Kg + ko, sp, wid, lane); load_tile128<1>(Vg + ko, sp + 16384, wid, lane); } while (0)
    SB_ISSUE(NT - 1, 0);
    const int qg = q0w + r;
    for (int ti = 0; ti < NT; ++ti) {
        const int kt = NT - 1 - ti;
        block_sync();
        if (ti > 0) { int alld = 1;
#pragma unroll
            for (int w = 0; w < 8; ++w) alld &= flags[((ti - 1) & 1) * 8 + w];
            if (alld) break; }
        if (ti + 1 < NT) SB_ISSUE(kt - 1, (ti + 1) & 1);
        int mydone = 0;
        if (64 * kt < q0w + 31) {
            if (!__all(R < -SB_CUT)) {
                const LAS unsigned char* sp = lds + (ti & 1) * STAGE;
                const bool masked = !(64 * kt + 63 < q0w);
#pragma unroll
                for (int kb = 1; kb >= 0; --kb) {
                    f32x16 x = qk_half_lq(sp + kb * 8192, qimg, r, h);
                    if (masked) sb_weights<true>(x, R, 64 * kt + 32 * kb, qg, h); else sb_weights<false>(x, R, 64 * kt + 32 * kb, qg, h);
                    pv_half<256>(o, x, sp + 16384, lane, kb);
                }
            }
            mydone = __all(R < -SB_CUT) ? 1 : 0;
        }
        if (lane == 0) flags[(ti & 1) * 8 + wid] = mydone;
    }
#undef SB_ISSUE
    bf16_t* orow = AO + (rowbase + q0w + r) * DM + 1024 + hd * 128 + 4 * h;
#pragma unroll
    for (int d = 0; d < 4; ++d)
#pragma unroll
        for (int g = 0; g < 4; ++g) { u32x2 w; w.x = cvtpk(o[d][4 * g], o[d][4 * g + 1]); w.y = cvtpk(o[d][4 * g + 2], o[d][4 * g + 3]); *(u32x2*)(orow + 32 * d + 8 * g) = w; }
    block_sync();
}
}

#define XB_TMO      128
#define XB_XCNT(j)  (256  + 64 * (j))
#define XB_XSUB(j)  (1280 + 64 * (j))
#define XB_XGEN(j)  (2304 + 64 * (j))
#define XB_TOP      3328
#define XB_TOPGEN   3392
#define XCD_BAR_WORDS 3456
#define XB_SPIN_CAP (1u << 18)

__device__ __forceinline__ unsigned xb_ld(unsigned* p)              { return __hip_atomic_load(p, __ATOMIC_RELAXED, __HIP_MEMORY_SCOPE_AGENT); }
__device__ __forceinline__ unsigned xb_add(unsigned* p, unsigned v) { return __hip_atomic_fetch_add(p, v, __ATOMIC_RELAXED, __HIP_MEMORY_SCOPE_AGENT); }
__device__ __forceinline__ unsigned xb_xcc_id() { return (unsigned)__builtin_amdgcn_s_getreg((3 << 11) | 20) & 0xFu; }
#define XB_SPIN(cond, bar) do { unsigned _sp = 0; while (cond) { __builtin_amdgcn_s_sleep(1); \
    if ((++_sp & 255u) == 0u) { if (xb_ld(&(bar)[XB_TMO])) break; if (_sp > XB_SPIN_CAP) { atomicAdd(&(bar)[XB_TMO], 1u); break; } } } } while (0)

struct XcdBarrier {
    unsigned* bar; unsigned x;
    volatile LAS unsigned* st;
};

__device__ __forceinline__ XcdBarrier xcd_barrier_post(unsigned* bar, volatile LAS unsigned* st) {
    XcdBarrier b; b.bar = bar; b.x = xb_xcc_id(); b.st = st;
    if (threadIdx.x == 0) (void)xb_add(&bar[XB_XCNT(b.x)], 1u);
    return b;
}
__device__ __forceinline__ void xcd_barrier_complete(unsigned* bar, unsigned x, unsigned& nloc, unsigned& nx) {
    const unsigned G = gridDim.x * gridDim.y * gridDim.z;
    unsigned sum, cnt, mine, sp = 0u;
    for (;;) {
        sum = 0u; cnt = 0u; mine = 0u;
#pragma unroll
        for (unsigned j = 0; j < 16; ++j) { const unsigned c = xb_ld(&bar[XB_XCNT(j)]); sum += c; cnt += (c > 0u) ? 1u : 0u; mine = (j == x) ? c : mine; }
        if (sum == G) break;
        __builtin_amdgcn_s_sleep(1);
        if ((++sp & 255u) == 0u) { if (xb_ld(&bar[XB_TMO])) break; if (sp > XB_SPIN_CAP) { atomicAdd(&bar[XB_TMO], 1u); break; } }
    }
    nloc = mine > 0u ? mine : 1u; nx = cnt > 0u ? cnt : 1u;
}

__device__ __forceinline__ void xcd_barrier(const XcdBarrier& b) {
    asm volatile("s_waitcnt vmcnt(0)" ::: "memory");
    __syncthreads();
    if (threadIdx.x == 0) {
        unsigned* bar = b.bar;
        __builtin_amdgcn_s_waitcnt(0);
        unsigned nloc = b.st[0], nx = b.st[1];
        if (nloc == 0u) { xcd_barrier_complete(bar, b.x, nloc, nx); b.st[0] = nloc; b.st[1] = nx; }
        const unsigned old = xb_add(&bar[XB_XSUB(b.x)], 1u);
        const unsigned gen = old / nloc;
        if (old + 1u == (gen + 1u) * nloc) {
            __builtin_amdgcn_fence(__ATOMIC_RELEASE, "agent");
            asm volatile("s_waitcnt vmcnt(0)" ::: "memory");
            const unsigned og = xb_add(&bar[XB_TOP], 1u);
            const unsigned tg = og / nx;
            if (og + 1u == (tg + 1u) * nx) xb_add(&bar[XB_TOPGEN], 1u);
            else XB_SPIN(xb_ld(&bar[XB_TOPGEN]) == tg, bar);
            __builtin_amdgcn_fence(__ATOMIC_ACQUIRE, "agent");
            xb_add(&bar[XB_XGEN(b.x)], 1u);
            asm volatile("s_waitcnt vmcnt(0)" ::: "memory");
        } else {
            XB_SPIN(xb_ld(&bar[XB_XGEN(b.x)]) == gen, bar);
            __builtin_amdgcn_fence(__ATOMIC_ACQUIRE, "agent");
            asm volatile("s_waitcnt vmcnt(0)" ::: "memory");
        }
    }
    __syncthreads();
}

struct Args { const float* in[20]; float* out; unsigned char* ws; };
enum { I_X = 0, I_N1, I_G1, I_U1, I_D1, I_NM, I_WIN, I_QN, I_KN, I_LQ1, I_LK1, I_LQ2, I_LK2, I_SUBLN, I_WOUT, I_N2, I_G2, I_U2, I_D2, I_NF };

__global__ void __launch_bounds__(NTHREADS, 2) fwd_megakernel(Args a) {
    extern __shared__ __attribute__((aligned(16))) unsigned char lds_raw[];
    LAS unsigned char* lds = (LAS unsigned char*)lds_raw;
    cg::grid_group grid = cg::this_grid();
    { volatile LAS unsigned* st0 = (volatile LAS unsigned*)(lds + MISC_OFF + 128); if (threadIdx.x == 0) { st0[0] = 0u; st0[1] = 0u; } __syncthreads(); }
    if (blockIdx.x == 0) for (int i = threadIdx.x; i < 16384; i += NTHREADS) ((unsigned*)(a.ws + WS_CTL))[i] = 0u;
#define GRID_BAR() xcd_barrier(xbar)
    const int G = gridDim.x, NGW = G * NWAVES;
    const int wid0 = __builtin_amdgcn_readfirstlane((int)threadIdx.x >> 6);
#define PHASE_IDS int lane = (int)__builtin_amdgcn_mbcnt_hi(~0u, __builtin_amdgcn_mbcnt_lo(~0u, 0u)); asm volatile("" : "+v"(lane)); const int wid = wid0, tid = wid * 64 + lane, gw = blockIdx.x * NWAVES + wid; (void)gw; (void)tid;
    unsigned char* ws = a.ws;
    unsigned* ctl = (unsigned*)(ws + WS_CTL);
    bf16_t* Wgu1 = (bf16_t*)(ws + WS_WGU1); bf16_t* Wd1 = (bf16_t*)(ws + WS_WD1); bf16_t* Win = (bf16_t*)(ws + WS_WIN); bf16_t* Wout = (bf16_t*)(ws + WS_WOUT);
    bf16_t* Wgu2 = (bf16_t*)(ws + WS_WGU2); bf16_t* Wd2 = (bf16_t*)(ws + WS_WD2);
    bf16_t* XN = (bf16_t*)(ws + WS_XN); bf16_t* BIG = (bf16_t*)(ws + WS_BIG);
    bf16_t* X1B = (bf16_t*)a.out; bf16_t* X2B = (bf16_t*)a.out + (size_t)M * DM;
    float* SSP = (float*)(ws + WS_SSP); LAS float* rsl = (LAS float*)(lds + pg8::RS_LDS_OFF);
    float* X = a.out;

    {
        PHASE_IDS
        LAS float* scr = (LAS float*)(lds + wid * 16384);
        constexpr int I_FF = (DM / 64) * (DFF / 32), I_DN = (DFF / 64) * (DM / 32), I_IN = (DM / 64) * (INC / 32), I_OUT = (DM / 64) * (DM / 32);
        constexpr int NITEMS = 4 * I_FF + 2 * I_DN + I_IN + I_OUT;
        for (int it = gw; it < NITEMS; it += NGW) {
            int r = it;
            if (r < I_FF) { transpose_item<false>(a.in[I_G1], DM, DFF, Wgu1, 1, 0, 0, 1.f, nullptr, scr, r, lane); continue; } r -= I_FF;
            if (r < I_FF) { transpose_item<false>(a.in[I_U1], DM, DFF, Wgu1, 2, 0, 0, 1.f, nullptr, scr, r, lane); continue; } r -= I_FF;
            if (r < I_DN) { transpose_item<false>(a.in[I_D1], DFF, DM, Wd1, 0, 0, 0, 1.f, nullptr, scr, r, lane); continue; } r -= I_DN;
            if (r < I_IN) { transpose_item<true>(a.in[I_WIN], DM, INC, Win, 0, 3072, 4096, QSCALE, a.in[I_NM], scr, r, lane); continue; } r -= I_IN;
            if (r < I_OUT) { transpose_item<false>(a.in[I_WOUT], DM, DM, Wout, 0, 0, 0, 1.f, nullptr, scr, r, lane); continue; } r -= I_OUT;
            if (r < I_FF) { transpose_item<true>(a.in[I_G2], DM, DFF, Wgu2, 1, 0, 0, 1.f, a.in[I_N2], scr, r, lane); continue; } r -= I_FF;
            if (r < I_FF) { transpose_item<true>(a.in[I_U2], DM, DFF, Wgu2, 2, 0, 0, 1.f, a.in[I_N2], scr, r, lane); continue; } r -= I_FF;
            transpose_item<false>(a.in[I_D2], DFF, DM, Wd2, 0, 0, 0, 1.f, nullptr, scr, r, lane);
        }
        rms_rows<false>(a.in[I_X], a.in[I_N1], XN, nullptr, gw, NGW, lane);
    }
    grid.sync();
    const XcdBarrier xbar = xcd_barrier_post((unsigned*)(a.ws + WS_CTL) + 4096, (volatile LAS unsigned*)(lds + MISC_OFF + 128));
    { pg8::Gemm g{XN, Wgu1, M, 2 * DFF, DM}; pg8::StaticOrder S; S.init(M, 2 * DFF, G, (int)blockIdx.x); pg8::EpiSwiGLU<false> E{BIG, DFF, rsl};
      pg8::gemm_phase<pg8::EpiSwiGLU<false>, pg8::StaticOrder, true, true>(lds, g, S, E, wid0); }
    GRID_BAR();
    { pg8::Gemm g{BIG, Wd1, M, DM, DFF}; pg8::StaticOrder S; S.init(M, DM, G, (int)blockIdx.x); typedef pg8::EpiResidB<false, 1, WS_SSP> Epi2; Epi2 E{a.in[I_X], X1B, DM, ws};
      pg8::gemm_phase<Epi2, pg8::StaticOrder, true, true>(lds, g, S, E, wid0); }
    GRID_BAR();
    { pg8::Gemm g{X1B, Win, M, INC, DM}; pg8::StaticOrder S; S.init(M, INC, G, (int)blockIdx.x); pg8::EpiQKV E{BIG, rsl, a.in[I_QN], a.in[I_KN]};
      { PHASE_IDS pg8::Unit u0; if (S.next(0, u0)) build_rs(rsl, SSP, u0.pm & ~7, wid, lane); else block_sync(); }
      pg8::gemm_phase<pg8::EpiQKV, pg8::StaticOrder, true, true>(lds, g, S, E, wid0); }
    GRID_BAR();
    {
        PHASE_IDS
        float lam;
        { const float p1 = a.in[I_LQ1][lane] * a.in[I_LK1][lane] + a.in[I_LQ1][lane + 64] * a.in[I_LK1][lane + 64];
          const float p2 = a.in[I_LQ2][lane] * a.in[I_LK2][lane] + a.in[I_LQ2][lane + 64] * a.in[I_LK2][lane + 64];
          lam = expf(wave_sum(p1, lane)) - expf(wave_sum(p2, lane)) + 0.2f; }
        volatile LAS int* sh = (volatile LAS int*)(lds + MISC_OFF);
        const int myx = (int)(__builtin_amdgcn_s_getreg((3 << 11) | 20) & 7u);
        for (int k = 0; k < 8; ++k) {
            const int qx = (myx + k) & 7; unsigned* cnt = ctl + 64 * (1 + qx);
            if (k == 1) { if (tid < 8) sh[8 + tid] = (int)__hip_atomic_load(ctl + 64 * (1 + tid), __ATOMIC_RELAXED, __HIP_MEMORY_SCOPE_AGENT); block_sync(); }
            if (k > 0 && sh[8 + qx] >= 128) continue;
            for (;;) {
                if (tid == 0) sh[0] = (int)atomicAdd(cnt, 1u);
                block_sync();
                const int idx = sh[0];
                block_sync();
                if (idx >= 128) break;
#ifndef NO_DIFF
                if (idx < 64) { const int sl = idx & 31, dbh = qx * 4 + 2 * (idx >> 5) + (sl >> 4), qi = sl & 15;
                    for (int rep = 0; rep < 2; ++rep) att::diff_unit(dbh, rep ? 31 - qi : qi, BIG, XN, a.in[I_SUBLN], lam, lds, wid, lane); }
#endif
#ifndef NO_SB
                if (idx >= 64) att::sb_unit(qx * 8 + ((idx - 64) >> 3), 7 - ((idx - 64) & 7), BIG, XN, lds, wid, lane);
#endif
            }
        }
    }
    GRID_BAR();
    { pg8::Gemm g{XN, Wout, M, DM, DM}; pg8::StaticOrder S; S.init(M, DM, G, (int)blockIdx.x); typedef pg8::EpiResidB<true, 2, WS_SSP + 2 * MiB> Epi4; Epi4 E{X1B, X2B, DM, ws};
      pg8::gemm_phase<Epi4, pg8::StaticOrder, true, true>(lds, g, S, E, wid0); }
    GRID_BAR();
    { pg8::Gemm g{X2B, Wgu2, M, 2 * DFF, DM}; pg8::StaticOrder S; S.init(M, 2 * DFF, G, (int)blockIdx.x); pg8::EpiSwiGLU<true> E{BIG, DFF, rsl};
      { PHASE_IDS pg8::Unit u0; if (S.next(0, u0)) build_rs(rsl, SSP + (size_t)M * 32, u0.pm & ~7, wid, lane); else block_sync(); }
      pg8::gemm_phase<pg8::EpiSwiGLU<true>, pg8::StaticOrder, true, true>(lds, g, S, E, wid0); }
    GRID_BAR();
    { pg8::Gemm g{BIG, Wd2, M, DM, DFF}; pg8::StaticOrder S; S.init(M, DM, G, (int)blockIdx.x); typedef pg8::EpiResidB<true, 1, WS_SSP + 4 * MiB> Epi6; Epi6 E{X2B, XN, DM, ws};
      pg8::gemm_phase<Epi6, pg8::StaticOrder, true, true>(lds, g, S, E, wid0); }
    GRID_BAR();
    { PHASE_IDS final_rows(X, XN, SSP + (size_t)M * 64, a.in[I_NF], gw, NGW, lane); }
}

extern "C" void kernel_launch(void* const* d_in, const int* in_sizes, int n_in, void* d_out, int out_size, void* d_ws, size_t ws_size, hipStream_t stream) {
    static int grid = 0;
    if (grid == 0) {
        if (n_in != 20 || out_size != M * DM || ws_size < WS_END) { fprintf(stderr, "kernel_launch: unexpected problem (n_in %d out %d ws %zu)\n", n_in, out_size, ws_size); grid = -1; return; }
        int dev = 0, cus = 0, per_cu = 0;
        (void)hipGetDevice(&dev); (void)hipDeviceGetAttribute(&cus, hipDeviceAttributeMultiprocessorCount, dev);
        (void)hipFuncSetAttribute((const void*)fwd_megakernel, hipFuncAttributeMaxDynamicSharedMemorySize, LDS_BYTES);
        (void)hipOccupancyMaxActiveBlocksPerMultiprocessor(&per_cu, (const void*)fwd_megakernel, NTHREADS, LDS_BYTES);
        if (per_cu < 1) { fprintf(stderr, "kernel_launch: occupancy query says %d blocks per CU\n", per_cu); per_cu = 1; }
        grid = cus * 1;
        (void)hipGetLastError();
    }
    if (grid < 0) return;
    Args a{};
    for (int i = 0; i < 20; ++i) a.in[i] = (const float*)d_in[i];
    a.out = (float*)d_out; a.ws = (unsigned char*)d_ws;
    void* args[] = {&a};
    hipError_t e = hipLaunchCooperativeKernel((const void*)fwd_megakernel, dim3(grid), dim3(NTHREADS), args, LDS_BYTES, stream);
    if (e != hipSuccess) fprintf(stderr, "cooperative launch failed: %s (grid %d)\n", hipGetErrorString(e), grid);
}
```
